# Optimizing an MI355X kernel written in HIP

```python
import math
import jax, jax.numpy as jnp
from jax import lax
import numpy as np

D_MODEL = 1024
BATCH = 2
SEQ = 8192
DEPTH = 2

HEAD_DIM = 64
GRID_W = 64
NQ_A = 4
NKV_A = 2
NQ_B = 4
NKV_B = 2
NH_C = 4
NQ_D = 4
NKV_D = 2
DIFF_DIM = HEAD_DIM // 2
BRANCH_W = 4 * HEAD_DIM
D_MIX = 4 * BRANCH_W
D_IN = (2 * NQ_A + 2 * NKV_A) * HEAD_DIM + (2 * NQ_B + 2 * NKV_B) * HEAD_DIM + 4 * NH_C * HEAD_DIM + (2 * NQ_D + 2 * NKV_D) * 2 * DIFF_DIM
Q_BLOCK = 128
WINDOW = 128
NA_KH = 8
NA_KW = 16
ROPE_THETA = 10000.0
EPS = 1e-6
NEG_INF = -1e30

kernel_name = "hybrid_parallel_heads_encoder"


def _in_sizes():
    hd, dd2 = HEAD_DIM, 2 * DIFF_DIM
    return [NQ_A * hd, NKV_A * hd, NKV_A * hd, NQ_A * hd,
            NQ_B * hd, NKV_B * hd, NKV_B * hd, NQ_B * hd,
            NH_C * hd, NH_C * hd, NH_C * hd, NH_C * hd,
            NQ_D * dd2, NKV_D * dd2, NKV_D * dd2, NQ_D * dd2]


def _rmsnorm(x, g):
    x32 = x.astype(jnp.float32)
    y = x32 * lax.rsqrt(jnp.mean(x32 * x32, axis=-1, keepdims=True) + EPS)
    return (y * g.astype(jnp.float32)).astype(x.dtype)


def _rope(x, pos):
    d = x.shape[-1]
    half = d // 2
    inv = jnp.power(ROPE_THETA, -jnp.arange(0, d, 2, dtype=jnp.float32) / d)
    ang = pos.astype(jnp.float32)[:, None] * inv[None, :]
    shp = (1, x.shape[1]) + (1,) * (x.ndim - 3) + (half,)
    cos = jnp.cos(ang).reshape(shp)
    sin = jnp.sin(ang).reshape(shp)
    x32 = x.astype(jnp.float32)
    x1, x2 = x32[..., :half], x32[..., half:]
    return jnp.concatenate([x1 * cos - x2 * sin, x2 * cos + x1 * sin], axis=-1).astype(x.dtype)


def _axial_rope(x, row, col):
    half = x.shape[-1] // 2
    return jnp.concatenate([_rope(x[..., :half], row), _rope(x[..., half:], col)], axis=-1)


def _dense_blocked(q, k, v, scale):
    b, s, hk, g, d = q.shape
    nb = s // Q_BLOCK
    qb = q.reshape(b, nb, Q_BLOCK, hk, g, d).transpose(1, 0, 2, 3, 4, 5)

    def body(qi):
        sc = jnp.einsum('bqkgd,bskd->bkgqs', qi, k).astype(jnp.float32) * scale
        p = jax.nn.softmax(sc, axis=-1).astype(v.dtype)
        return jnp.einsum('bkgqs,bskd->bqkgd', p, v)

    o = lax.map(body, qb)
    return o.transpose(1, 0, 2, 3, 4, 5).reshape(b, s, hk * g * v.shape[-1])


def _window_sink(q, k, v, sink, scale):
    b, s, hk, g, d = q.shape
    nb = s // Q_BLOCK
    pad = ((0, 0), (Q_BLOCK, Q_BLOCK), (0, 0), (0, 0))
    kp = jnp.pad(k, pad).reshape(b, nb + 2, Q_BLOCK, hk, d)
    vp = jnp.pad(v, pad).reshape(b, nb + 2, Q_BLOCK, hk, v.shape[-1])
    kw = jnp.concatenate([kp[:, :-2], kp[:, 1:-1], kp[:, 2:]], axis=2)
    vw = jnp.concatenate([vp[:, :-2], vp[:, 1:-1], vp[:, 2:]], axis=2)
    qb = q.reshape(b, nb, Q_BLOCK, hk, g, d)
    sc = jnp.einsum('bnqkgd,bnskd->bnkgqs', qb, kw).astype(jnp.float32) * scale
    blk = jnp.arange(nb)[:, None] * Q_BLOCK
    qpos = blk + jnp.arange(Q_BLOCK)[None, :]
    kpos = blk - Q_BLOCK + jnp.arange(3 * Q_BLOCK)[None, :]
    valid = ((jnp.abs(qpos[:, :, None] - kpos[:, None, :]) <= WINDOW)
             & (kpos[:, None, :] >= 0) & (kpos[:, None, :] < s))
    sc = jnp.where(valid[None, :, None, None], sc, NEG_INF)
    sk = jnp.broadcast_to(sink.astype(jnp.float32).reshape(1, 1, hk, g, 1, 1), sc.shape[:-1] + (1,))
    p = jax.nn.softmax(jnp.concatenate([sc, sk], axis=-1), axis=-1)[..., :-1].astype(v.dtype)
    o = jnp.einsum('bnkgqs,bnskd->bnqkgd', p, vw)
    return o.reshape(b, s, hk * g * v.shape[-1])


def _neighbourhood(q, k, v, rpb, scale):
    b, s, h, d = q.shape
    rows = s // GRID_W
    kh = min(NA_KH, rows)
    kw = NA_KW
    ncb = GRID_W // kw
    kc = 2 * kw
    nl = kh * kc
    r = jnp.arange(rows)
    rs = jnp.clip(r - kh // 2, 0, rows - kh)
    key_rows = rs[:, None] + jnp.arange(kh)[None, :]
    cb = jnp.arange(ncb)
    cbase = jnp.clip(cb * kw - kw // 2, 0, GRID_W - kc)
    key_cols = cbase[:, None] + jnp.arange(kc)[None, :]
    idx = (key_rows[:, None, :, None] * GRID_W + key_cols[None, :, None, :]).reshape(-1)
    kg = jnp.take(k, idx, axis=1).reshape(b, rows, ncb, nl, h, d)
    vg = jnp.take(v, idx, axis=1).reshape(b, rows, ncb, nl, h, v.shape[-1])
    qg = q.reshape(b, rows, ncb, kw, h, d)
    sc = jnp.einsum('brcqhd,brclhd->brchql', qg, kg).astype(jnp.float32) * scale
    qcol = cb[:, None] * kw + jnp.arange(kw)[None, :]
    cs = jnp.clip(qcol - kw // 2, 0, GRID_W - kw)
    kcol = key_cols[:, None, :]
    col_ok = (kcol >= cs[:, :, None]) & (kcol < cs[:, :, None] + kw)
    mask = jnp.broadcast_to(col_ok[:, :, None, :], (ncb, kw, kh, kc)).reshape(ncb, kw, nl)
    dr = key_rows - r[:, None] + NA_KH - 1
    dc = jnp.clip(kcol - qcol[:, :, None], -(kw - 1), kw - 1) + kw - 1
    bias = rpb.astype(jnp.float32)[:, dr[:, None, None, :, None], dc[None, :, :, None, :]]
    bias = bias.reshape(h, rows, ncb, kw, nl).transpose(1, 2, 0, 3, 4)
    sc = jnp.where(mask[None, None, :, None], sc + bias[None], NEG_INF)
    p = jax.nn.softmax(sc, axis=-1).astype(v.dtype)
    o = jnp.einsum('brchql,brclhd->brcqhd', p, vg)
    return o.reshape(b, s, h * v.shape[-1])


def _diff_blocked(q, k, v, lam, scale):
    b, s, hk, g, _, dd = q.shape
    nb = s // Q_BLOCK
    qb = q.reshape(b, nb, Q_BLOCK, hk, g, 2, dd).transpose(1, 0, 2, 3, 4, 5, 6)

    def body(qi):
        sc = jnp.einsum('bqkgcd,bskcd->cbkgqs', qi, k).astype(jnp.float32) * scale
        p = jax.nn.softmax(sc, axis=-1)
        w = (p[0] - lam * p[1]).astype(v.dtype)
        return jnp.einsum('bkgqs,bskd->bqkgd', w, v)

    o = lax.map(body, qb)
    return o.transpose(1, 0, 2, 3, 4, 5).reshape(b, s, hk, g, v.shape[-1])


def setup_inputs(seed: int = 0) -> dict:
    key = jax.random.key(seed)
    ks = jax.random.split(key, 14)
    f32 = jnp.float32
    nrm = lambda k, shp: jax.random.normal(k, shp, dtype=f32)
    return {
        "x": nrm(ks[0], (BATCH, SEQ, D_MODEL)),
        "norm_g": 1.0 + 0.02 * nrm(ks[1], (DEPTH, D_MODEL)),
        "w_in": nrm(ks[2], (DEPTH, D_MODEL, D_IN)) * D_MODEL ** -0.5,
        "w_out": nrm(ks[3], (DEPTH, D_MIX, D_MODEL)) * D_MIX ** -0.5,
        "qn_a": 1.0 + 0.02 * nrm(ks[4], (DEPTH, HEAD_DIM)),
        "kn_a": 1.0 + 0.02 * nrm(ks[5], (DEPTH, HEAD_DIM)),
        "sink_b": 0.5 * nrm(ks[6], (DEPTH, NQ_B)),
        "rpb_c": 0.1 * nrm(ks[7], (DEPTH, NH_C, 2 * NA_KH - 1, 2 * NA_KW - 1)),
        "lam_q1": 0.1 * nrm(ks[8], (DEPTH, DIFF_DIM)),
        "lam_k1": 0.1 * nrm(ks[9], (DEPTH, DIFF_DIM)),
        "lam_q2": 0.1 * nrm(ks[10], (DEPTH, DIFF_DIM)),
        "lam_k2": 0.1 * nrm(ks[11], (DEPTH, DIFF_DIM)),
        "subln_d": 1.0 + 0.02 * nrm(ks[12], (DEPTH, 2 * DIFF_DIM)),
        "final_g": 1.0 + 0.02 * nrm(ks[13], (D_MODEL,)),
    }


def reference(x, norm_g, w_in, w_out, qn_a, kn_a, sink_b, rpb_c, lam_q1, lam_k1, lam_q2, lam_k2, subln_d, final_g):
    b, s, _ = x.shape
    t = jnp.arange(s)
    row = t // GRID_W
    col = t % GRID_W
    offs = [int(o) for o in np.cumsum(_in_sizes())[:-1]]
    sc_hd = HEAD_DIM ** -0.5
    for l in range(DEPTH):
        h = _rmsnorm(x, norm_g[l])
        z = jnp.einsum('bsd,de->bse', h, w_in[l])
        (q_a, k_a, v_a, g_a, q_b, k_b, v_b, g_b,
         q_c, k_c, v_c, g_c, q_d, k_d, v_d, g_d) = jnp.split(z, offs, axis=-1)

        q_a = _rmsnorm(q_a.reshape(b, s, NKV_A, NQ_A // NKV_A, HEAD_DIM), qn_a[l])
        k_a = _rmsnorm(k_a.reshape(b, s, NKV_A, HEAD_DIM), kn_a[l])
        q_a = _axial_rope(q_a, row, col)
        k_a = _axial_rope(k_a, row, col)
        o_a = _dense_blocked(q_a, k_a, v_a.reshape(b, s, NKV_A, HEAD_DIM), sc_hd)

        q_b = _rope(q_b.reshape(b, s, NKV_B, NQ_B // NKV_B, HEAD_DIM), t)
        k_b = _rope(k_b.reshape(b, s, NKV_B, HEAD_DIM), t)
        o_b = _window_sink(q_b, k_b, v_b.reshape(b, s, NKV_B, HEAD_DIM), sink_b[l], sc_hd)

        o_c = _neighbourhood(q_c.reshape(b, s, NH_C, HEAD_DIM), k_c.reshape(b, s, NH_C, HEAD_DIM),
                             v_c.reshape(b, s, NH_C, HEAD_DIM), rpb_c[l], sc_hd)

        lam_init = 0.8 - 0.6 * math.exp(-0.3 * l)
        lam = (jnp.exp(jnp.sum(lam_q1[l].astype(jnp.float32) * lam_k1[l].astype(jnp.float32)))
               - jnp.exp(jnp.sum(lam_q2[l].astype(jnp.float32) * lam_k2[l].astype(jnp.float32)))
               + lam_init)
        q_d = _rope(q_d.reshape(b, s, NKV_D, NQ_D // NKV_D, 2, DIFF_DIM), t)
        k_d = _rope(k_d.reshape(b, s, NKV_D, 2, DIFF_DIM), t)
        o_d = _diff_blocked(q_d, k_d, v_d.reshape(b, s, NKV_D, 2 * DIFF_DIM), lam, DIFF_DIM ** -0.5)
        o_d = (_rmsnorm(o_d, subln_d[l]) * (1.0 - lam_init)).reshape(b, s, NQ_D * 2 * DIFF_DIM)

        mix = jnp.concatenate([o_a * jax.nn.silu(g_a), o_b * jax.nn.silu(g_b),
                               o_c * jax.nn.silu(g_c), o_d * jax.nn.silu(g_d)], axis=-1)
        x = x + jnp.einsum('bsm,md->bsd', mix, w_out[l])
    return _rmsnorm(x, final_g)
```

```cpp
#include <hip/hip_runtime.h>
#include <hip/hip_cooperative_groups.h>
#include <cstdio>
#include <cstdint>
namespace cg = cooperative_groups;

#define DI __device__ __forceinline__
typedef unsigned short bf16_t;
typedef short bf16x8 __attribute__((ext_vector_type(8)));
typedef short s16x4 __attribute__((ext_vector_type(4)));
typedef float f32x16 __attribute__((ext_vector_type(16)));
typedef float f32x4 __attribute__((ext_vector_type(4)));
typedef float f32x2 __attribute__((ext_vector_type(2)));
typedef __bf16 bf16x2_t __attribute__((ext_vector_type(2)));
typedef unsigned u32x2 __attribute__((ext_vector_type(2)));
typedef unsigned u32x4 __attribute__((ext_vector_type(4)));

#define MFMA(a, b, c) __builtin_amdgcn_mfma_f32_32x32x16_bf16((a), (b), (c), 0, 0, 0)

constexpr int SEQ = 8192, DM = 1024, DIN = 3328, MTOK = 16384;
constexpr float LOG2E = 1.4426950408889634f;
constexpr float EPSV = 1e-6f;
constexpr float NEG = -1e30f;

constexpr size_t MiB = 1024 * 1024;
constexpr size_t OFF_BAR = 0;
constexpr size_t OFF_CTRL = 16384;
constexpr size_t OFF_T32 = 20480;
constexpr size_t OFF_WIN = OFF_T32 + 2 * MiB;
constexpr size_t OFF_WOUT = OFF_WIN + 13 * MiB;
constexpr size_t OFF_H = OFF_WOUT + 4 * MiB;
constexpr size_t OFF_QA = OFF_H + 32 * MiB;
constexpr size_t OFF_KA = OFF_QA + 8 * MiB;
constexpr size_t OFF_VA = OFF_KA + 4 * MiB;
constexpr size_t OFF_QB = OFF_VA + 4 * MiB;
constexpr size_t OFF_KB = OFF_QB + 8 * MiB;
constexpr size_t OFF_VB = OFF_KB + 4 * MiB;
constexpr size_t OFF_QC = OFF_VB + 4 * MiB;
constexpr size_t OFF_KC = OFF_QC + 8 * MiB;
constexpr size_t OFF_VC = OFF_KC + 8 * MiB;
constexpr size_t OFF_QD = OFF_VC + 8 * MiB;
constexpr size_t OFF_KD = OFF_QD + 8 * MiB;
constexpr size_t OFF_VD = OFF_KD + 4 * MiB;
constexpr size_t OFF_GATE = OFF_VD + 4 * MiB;
constexpr size_t OFF_X1 = OFF_GATE + 32 * MiB;
constexpr size_t OFF_MIX = OFF_X1 + 64 * MiB;
constexpr size_t WS_NEEDED = OFF_MIX + 32 * MiB;

struct Params {
  const float *x, *norm_g, *w_in, *w_out, *qn_a, *kn_a, *sink_b, *rpb_c, *lq1, *lk1, *lq2, *lk2, *subln, *final_g;
  float* out;
  char* ws;
};

__device__ const float INV32[32] = {
    1.000000000e+00f, 7.498942614e-01f, 5.623413324e-01f, 4.216965139e-01f, 3.162277639e-01f, 2.371373773e-01f,
    1.778279394e-01f, 1.333521307e-01f, 1.000000015e-01f, 7.498941571e-02f, 5.623413250e-02f, 4.216965288e-02f,
    3.162277490e-02f, 2.371373773e-02f, 1.778279431e-02f, 1.333521493e-02f, 9.999999776e-03f, 7.498941850e-03f,
    5.623413250e-03f, 4.216964822e-03f, 3.162277630e-03f, 2.371373586e-03f, 1.778279431e-03f, 1.333521446e-03f,
    1.000000047e-03f, 7.498942432e-04f, 5.623413017e-04f, 4.216965172e-04f, 3.162277571e-04f, 2.371373703e-04f,
    1.778279402e-04f, 1.333521504e-04f};

DI unsigned pk2(float a, float b) {
  f32x2 v = {a, b};
  return __builtin_bit_cast(unsigned, __builtin_convertvector(v, bf16x2_t));
}
DI float bf2f(unsigned short u) { return __uint_as_float(((unsigned)u) << 16); }
DI int crow(int reg, int h) { return (reg & 3) + 8 * (reg >> 2) + 4 * h; }
DI float xor32(float v) { return __shfl_xor(v, 32); }
DI __amdgpu_buffer_rsrc_t mk_rsrc(const void* base) { return __builtin_amdgcn_make_buffer_rsrc((void*)base, 0, 0x7fffffff, 0x00020000); }
DI u32x4 ld16(__amdgpu_buffer_rsrc_t rs, size_t byte_off) { return __builtin_amdgcn_raw_buffer_load_b128(rs, (int)(unsigned)byte_off, 0, 16); }
DI u32x2 ld8(__amdgpu_buffer_rsrc_t rs, size_t byte_off) { return __builtin_amdgcn_raw_buffer_load_b64(rs, (int)(unsigned)byte_off, 0, 16); }
DI unsigned ld4(__amdgpu_buffer_rsrc_t rs, size_t byte_off) { return __builtin_amdgcn_raw_buffer_load_b32(rs, (int)(unsigned)byte_off, 0, 16); }
DI int opaque_tid() { int t = threadIdx.x; asm volatile("" : "+v"(t)); return t; }


#define XB_TMO      128
#define XB_XCNT(j)  (256  + 64 * (j))
#define XB_XSUB(j)  (1280 + 64 * (j))
#define XB_XGEN(j)  (2304 + 64 * (j))
#define XB_TOP      3328
#define XB_TOPGEN   3392
#define XCD_BAR_WORDS 3456
#define XB_SPIN_CAP (1u << 20)
#define LAS __attribute__((address_space(3)))
DI unsigned xb_ld(unsigned* p) { return __hip_atomic_load(p, __ATOMIC_RELAXED, __HIP_MEMORY_SCOPE_AGENT); }
DI unsigned xb_add(unsigned* p, unsigned v) { return __hip_atomic_fetch_add(p, v, __ATOMIC_RELAXED, __HIP_MEMORY_SCOPE_AGENT); }
DI unsigned xb_xcc_id() { return (unsigned)__builtin_amdgcn_s_getreg((3 << 11) | 20) & 0xFu; }
#define XB_SPIN(cond, bar) do { unsigned _sp = 0; while (cond) { __builtin_amdgcn_s_sleep(1); \
    if ((++_sp & 255u) == 0u) { if (xb_ld(&(bar)[XB_TMO])) break; if (_sp > XB_SPIN_CAP) { atomicAdd(&(bar)[XB_TMO], 1u); break; } } } } while (0)
struct XcdBarrier { unsigned* bar; unsigned x; volatile LAS unsigned* st; };
DI XcdBarrier xcd_barrier_post(unsigned* bar, volatile LAS unsigned* st) {
  XcdBarrier b; b.bar = bar; b.x = xb_xcc_id(); b.st = st;
  if (threadIdx.x == 0) (void)xb_add(&bar[XB_XCNT(b.x)], 1u);
  return b;
}
DI void xcd_barrier_complete(unsigned* bar, unsigned x, unsigned& nloc, unsigned& nx) {
  const unsigned G = gridDim.x * gridDim.y * gridDim.z;
  unsigned sum, cnt, mine, sp = 0u;
  for (;;) {
    sum = 0u; cnt = 0u; mine = 0u;
#pragma unroll
    for (unsigned j = 0; j < 16; ++j) { const unsigned c = xb_ld(&bar[XB_XCNT(j)]); sum += c; cnt += (c > 0u) ? 1u : 0u; mine = (j == x) ? c : mine; }
    if (sum == G) break;
    __builtin_amdgcn_s_sleep(1);
    if ((++sp & 255u) == 0u) { if (xb_ld(&bar[XB_TMO])) break; if (sp > XB_SPIN_CAP) { atomicAdd(&bar[XB_TMO], 1u); break; } }
  }
  nloc = mine > 0u ? mine : 1u; nx = cnt > 0u ? cnt : 1u;
}
DI void xcd_barrier(const XcdBarrier& b) {
  asm volatile("s_waitcnt vmcnt(0)" ::: "memory");
  __syncthreads();
  if (threadIdx.x == 0) {
    unsigned* bar = b.bar;
    asm volatile("" : "+s"(bar));
    __builtin_amdgcn_s_waitcnt(0);
    unsigned nloc = b.st[0], nx = b.st[1];
    if (nloc == 0u) { xcd_barrier_complete(bar, b.x, nloc, nx); b.st[0] = nloc; b.st[1] = nx; }
    unsigned bx = b.x;
    asm volatile("" : "+s"(bx));
    const unsigned old = xb_add(&bar[XB_XSUB(bx)], 1u);
    const unsigned gen = old / nloc;
    if (old + 1u == (gen + 1u) * nloc) {
      __builtin_amdgcn_fence(__ATOMIC_RELEASE, "agent");
      asm volatile("s_waitcnt vmcnt(0)" ::: "memory");
      const unsigned og = xb_add(&bar[XB_TOP], 1u);
      const unsigned tg = og / nx;
      if (og + 1u == (tg + 1u) * nx) xb_add(&bar[XB_TOPGEN], 1u);
      else XB_SPIN(xb_ld(&bar[XB_TOPGEN]) == tg, bar);
      __builtin_amdgcn_fence(__ATOMIC_ACQUIRE, "agent");
      xb_add(&bar[XB_XGEN(bx)], 1u);
      asm volatile("s_waitcnt vmcnt(0)" ::: "memory");
    } else {
      XB_SPIN(xb_ld(&bar[XB_XGEN(bx)]) == gen, bar);
      __builtin_amdgcn_fence(__ATOMIC_ACQUIRE, "agent");
      asm volatile("s_waitcnt vmcnt(0)" ::: "memory");
    }
  }
  __syncthreads();
}

DI void sincos_d(float angf, float& sn, float& cs) {
  const double a = (double)angf;
  const double q = __builtin_rint(a * 0.63661977236758134308);
  double r = __builtin_fma(-q, 1.57079632679489655800e+00, a);
  r = __builtin_fma(-q, 6.12323399573676603587e-17, r);
  const int n = ((int)q) & 3;
  const double r2 = r * r;
  double sp = 1.0 / 6227020800.0;
  sp = sp * r2 - 1.0 / 39916800.0;
  sp = sp * r2 + 1.0 / 362880.0;
  sp = sp * r2 - 1.0 / 5040.0;
  sp = sp * r2 + 1.0 / 120.0;
  sp = sp * r2 - 1.0 / 6.0;
  sp = r + r * r2 * sp;
  double cp = -1.0 / 87178291200.0;
  cp = cp * r2 + 1.0 / 479001600.0;
  cp = cp * r2 - 1.0 / 3628800.0;
  cp = cp * r2 + 1.0 / 40320.0;
  cp = cp * r2 - 1.0 / 720.0;
  cp = cp * r2 + 1.0 / 24.0;
  cp = cp * r2 - 0.5;
  cp = 1.0 + r2 * cp;
  double s_, c_;
  if (n == 0) { s_ = sp; c_ = cp; }
  else if (n == 1) { s_ = cp; c_ = -sp; }
  else if (n == 2) { s_ = -sp; c_ = -cp; }
  else { s_ = -cp; c_ = sp; }
  sn = (float)s_; cs = (float)c_;
}

__device__ void wconv_tile(const float* __restrict__ W, const float* __restrict__ g, bf16_t* __restrict__ Wt, int N, int tile, float* lds, const int tid) {
  const int ntn = N >> 6;
  const int k0 = (tile / ntn) << 6, n0 = (tile % ntn) << 6;
  __syncthreads();
#pragma unroll
  for (int i = 0; i < 16; ++i) {
    const int k = i * 4 + (tid >> 6), n = tid & 63;
    float v = W[(size_t)(k0 + k) * N + n0 + n];
    if (g) v *= g[k0 + k];
    lds[k * 65 + n] = v;
  }
  __syncthreads();
#pragma unroll
  for (int i = 0; i < 16; ++i) {
    const int n = i * 4 + (tid >> 6), k = tid & 63;
    Wt[(size_t)(n0 + n) * 1024 + k0 + k] = (bf16_t)(pk2(lds[k * 65 + n], 0.f) & 0xffffu);
  }
}

template <bool FINAL>
__device__ void rms_rows(const float* X, bf16_t* H, float* O, const float* g) {
  const int t_ = opaque_tid();
  const int lane = t_ & 63;
  const int gw = (blockIdx.x * blockDim.x + t_) >> 6, nw = (gridDim.x * blockDim.x) >> 6;
  const __amdgpu_buffer_rsrc_t rsx = mk_rsrc(X);
  const __amdgpu_buffer_rsrc_t rso = mk_rsrc(FINAL ? (const void*)O : (const void*)X);
  for (int row = gw; row < MTOK; row += nw) {
    f32x4 v[4];
    float ss = 0.f;
#pragma unroll
    for (int i = 0; i < 4; ++i) {
      v[i] = __builtin_bit_cast(f32x4, ld16(rsx, ((size_t)row * DM + i * 256 + lane * 4) * 4));
      ss += v[i][0] * v[i][0] + v[i][1] * v[i][1] + v[i][2] * v[i][2] + v[i][3] * v[i][3];
    }
#pragma unroll
    for (int o = 32; o >= 1; o >>= 1) ss += __shfl_xor(ss, o);
    const float rstd = rsqrtf(ss * (1.0f / DM) + EPSV);
#pragma unroll
    for (int i = 0; i < 4; ++i) {
      if (FINAL) {
        const f32x4 gg = *(const f32x4*)(g + i * 256 + lane * 4);
        f32x4 o = v[i] * rstd * gg;
        __builtin_amdgcn_raw_buffer_store_b128(__builtin_bit_cast(u32x4, o), rso, (int)(unsigned)(((size_t)row * DM + i * 256 + lane * 4) * 4), 0, 16);
      } else {
        u32x2 o;
        o[0] = pk2(v[i][0] * rstd, v[i][1] * rstd);
        o[1] = pk2(v[i][2] * rstd, v[i][3] * rstd);
        *(u32x2*)(H + (size_t)row * DM + i * 256 + lane * 4) = o;
      }
    }
  }
}

constexpr int LROW = 144;
template <bool SWAP>
DI void gemm_mainloop(const bf16_t* __restrict__ A, const bf16_t* __restrict__ Bm, int m0, int n0, char* lds, f32x16 (&acc)[1][2]) {
  const int tid = opaque_tid(), w = tid >> 6, lane = tid & 63, r = lane & 31, h = lane >> 5;
  const int wm = w & 3, wn = w >> 2;
#pragma unroll
  for (int j = 0; j < 2; ++j)
#pragma unroll
    for (int e = 0; e < 16; ++e) acc[0][j][e] = 0.f;
  u32x4 ra[2], rb[2];
  const __amdgpu_buffer_rsrc_t rsa = mk_rsrc(A), rsb = mk_rsrc(Bm);
  const unsigned oa = (unsigned)(((size_t)(m0 + (tid >> 3)) * 1024 + (tid & 7) * 8) * 2);
  const unsigned ob = (unsigned)(((size_t)(n0 + (tid >> 3)) * 1024 + (tid & 7) * 8) * 2);
#pragma unroll
  for (int i = 0; i < 2; ++i) {
    ra[i] = ld16(rsa, oa + i * 64 * 2048);
    rb[i] = ld16(rsb, ob + i * 64 * 2048);
  }
  const int soff = (tid >> 3) * LROW + (tid & 7) * 16;
  __syncthreads();
#pragma unroll
  for (int i = 0; i < 2; ++i) {
    *(u32x4*)(lds + soff + i * 64 * LROW) = ra[i];
    *(u32x4*)(lds + 128 * LROW + soff + i * 64 * LROW) = rb[i];
  }
#pragma unroll
  for (int i = 0; i < 2; ++i) {
    ra[i] = ld16(rsa, oa + i * 64 * 2048 + 128);
    rb[i] = ld16(rsb, ob + i * 64 * 2048 + 128);
  }
  __syncthreads();
  for (int kt = 0; kt < 16; ++kt) {
    const char* ldsA = lds + (kt & 1) * 256 * LROW;
    const char* ldsB = ldsA + 128 * LROW;
    if (kt + 1 < 16) {
      char* nb = lds + ((kt + 1) & 1) * 256 * LROW;
#pragma unroll
      for (int i = 0; i < 2; ++i) {
        *(u32x4*)(nb + soff + i * 64 * LROW) = ra[i];
        *(u32x4*)(nb + 128 * LROW + soff + i * 64 * LROW) = rb[i];
      }
    }
    if (kt + 2 < 16) {
#pragma unroll
      for (int i = 0; i < 2; ++i) {
        ra[i] = ld16(rsa, oa + i * 64 * 2048 + (kt + 2) * 128);
        rb[i] = ld16(rsb, ob + i * 64 * 2048 + (kt + 2) * 128);
      }
    }
    __builtin_amdgcn_sched_barrier(0);
#pragma unroll
    for (int ks = 0; ks < 4; ++ks) {
      const bf16x8 af = *(const bf16x8*)(ldsA + (32 * wm + r) * LROW + (16 * ks + 8 * h) * 2);
      bf16x8 bfr[2];
#pragma unroll
      for (int j = 0; j < 2; ++j) bfr[j] = *(const bf16x8*)(ldsB + (64 * wn + 32 * j + r) * LROW + (16 * ks + 8 * h) * 2);
#pragma unroll
      for (int j = 0; j < 2; ++j) {
        if (SWAP) acc[0][j] = MFMA(bfr[j], af, acc[0][j]);
        else acc[0][j] = MFMA(af, bfr[j], acc[0][j]);
      }
    }
    __syncthreads();
  }
}

__device__ void inproj_tile(const Params& p, int l, int tile, char* lds) {
  const int tid = opaque_tid(), w = tid >> 6, lane = tid & 63, r = lane & 31, h = lane >> 5;
  const int wm = w & 3, wn = w >> 2;
  const int nt = tile % 26, mt = tile / 26;
  const int m0 = mt * 128, n0 = nt * 128;
  const bf16_t* Hb = (const bf16_t*)(p.ws + OFF_H);
  const bf16_t* Wt = (const bf16_t*)(p.ws + OFF_WIN) + (size_t)l * DIN * 1024;
  const bool isV = (nt == 3) || (nt == 9) || (nt == 16) || (nt == 17) || (nt == 23);
  const int hc = (n0 >> 6) + wn;
  f32x16 acc[1][2];
  if (isV) {
    gemm_mainloop<false>(Hb, Wt, m0, n0, lds, acc);
    bf16_t* dst; int nh, vh;
    if (hc < 8) { dst = (bf16_t*)(p.ws + OFF_VA); nh = 2; vh = hc - 6; }
    else if (hc < 20) { dst = (bf16_t*)(p.ws + OFF_VB); nh = 2; vh = hc - 18; }
    else if (hc < 36) { dst = (bf16_t*)(p.ws + OFF_VC); nh = 4; vh = hc - 32; }
    else { dst = (bf16_t*)(p.ws + OFF_VD); nh = 2; vh = hc - 46; }
    const int b = m0 >> 13, s0 = (m0 & 8191) + 32 * wm;
#pragma unroll
    for (int i = 0; i < 1; ++i)
#pragma unroll
      for (int j = 0; j < 2; ++j) {
        const int d = 32 * j + r;
        bf16_t* row = dst + ((size_t)(b * nh + vh) * 64 + d) * SEQ + s0 + 32 * i + 4 * h;
#pragma unroll
        for (int g = 0; g < 4; ++g) {
          u32x2 o;
          o[0] = pk2(acc[i][j][4 * g + 0], acc[i][j][4 * g + 1]);
          o[1] = pk2(acc[i][j][4 * g + 2], acc[i][j][4 * g + 3]);
          *(u32x2*)(row + 8 * g) = o;
        }
      }
    return;
  }
  gemm_mainloop<true>(Hb, Wt, m0, n0, lds, acc);
  int branch, idx;
  if (hc < 12) { branch = 0; idx = hc; }
  else if (hc < 24) { branch = 1; idx = hc - 12; }
  else if (hc < 40) { branch = 2; idx = hc - 24; }
  else { branch = 3; idx = hc - 40; }
  int kind, head;
  if (branch == 2) {
    if (idx < 4) { kind = 0; head = idx; } else if (idx < 8) { kind = 1; head = idx - 4; } else { kind = 3; head = idx - 12; }
  } else {
    if (idx < 4) { kind = 0; head = idx; } else if (idx < 6) { kind = 1; head = idx - 4; } else { kind = 3; head = idx - 8; }
  }
  constexpr int RROW = 272;
  const bool needs_rope = (kind != 3) && (branch != 2);
  if (needs_rope) {
    const int s0 = m0 & 8191;
    const __amdgpu_buffer_rsrc_t rst = mk_rsrc(p.ws + OFF_T32);
    if (branch == 0) {
      for (int idx = tid; idx < 66 * 16; idx += 512) {
        const int row = idx >> 4, c = idx & 15;
        const int pos = row < 64 ? row : (s0 >> 6) + (row - 64);
        *(u32x4*)(lds + row * RROW + c * 16) = ld16(rst, (size_t)(pos * 16 + c) * 16);
      }
      if (tid < 64) ((float*)(lds + 66 * RROW))[tid] = (kind == 0 ? p.qn_a : p.kn_a)[l * 64 + tid];
    } else {
      for (int idx = tid; idx < 128 * 16; idx += 512) {
        const int row = idx >> 4, c = idx & 15;
        *(u32x4*)(lds + row * RROW + c * 16) = ld16(rst, (size_t)((s0 + row) * 16 + c) * 16);
      }
    }
    __syncthreads();
  }
  const float* gl = (const float*)(lds + 66 * RROW);
#pragma unroll
  for (int i = 0; i < 1; ++i) {
    const int token = m0 + 32 * wm + r;
    const int tl = 32 * wm + r;
    const int b = token >> 13, s = token & 8191;
    f32x16 v0 = acc[i][0], v1 = acc[i][1];
    if (kind == 3) {
      bf16_t* dst = (bf16_t*)(p.ws + OFF_GATE) + (size_t)token * 1024 + branch * 256 + head * 64 + 4 * h;
#pragma unroll
      for (int g = 0; g < 4; ++g) {
        float t[8];
#pragma unroll
        for (int e = 0; e < 4; ++e) {
          const float a0 = v0[4 * g + e], a1 = v1[4 * g + e];
          t[e] = a0 * __builtin_amdgcn_rcpf(1.f + __builtin_amdgcn_exp2f(-a0 * LOG2E));
          t[4 + e] = a1 * __builtin_amdgcn_rcpf(1.f + __builtin_amdgcn_exp2f(-a1 * LOG2E));
        }
        u32x2 o0, o1;
        o0[0] = pk2(t[0], t[1]); o0[1] = pk2(t[2], t[3]);
        o1[0] = pk2(t[4], t[5]); o1[1] = pk2(t[6], t[7]);
        *(u32x2*)(dst + 8 * g) = o0;
        *(u32x2*)(dst + 32 + 8 * g) = o1;
      }
      continue;
    }
    if (branch == 0) {
      float ss = 0.f;
#pragma unroll
      for (int e = 0; e < 16; ++e) ss += v0[e] * v0[e] + v1[e] * v1[e];
      ss += xor32(ss);
      const float rstd = rsqrtf(ss * (1.f / 64.f) + EPSV);
#pragma unroll
      for (int e = 0; e < 16; ++e) {
        v0[e] = v0[e] * rstd * gl[crow(e, h)];
        v1[e] = v1[e] * rstd * gl[32 + crow(e, h)];
      }
    }
    if (branch == 0 || branch == 3) {
      const int row0 = (branch == 0) ? (64 + (tl >> 6)) : tl;
      const int row1 = (branch == 0) ? (tl & 63) : tl;
#pragma unroll
      for (int e = 0; e < 8; ++e) {
        const int jf = crow(e, h);
        const float2 c0 = *(const float2*)(lds + row0 * RROW + jf * 16);
        const float2 c1 = *(const float2*)(lds + row1 * RROW + jf * 16);
        const float a1 = v0[e], a2 = v0[e + 8];
        v0[e] = a1 * c0.x - a2 * c0.y; v0[e + 8] = a2 * c0.x + a1 * c0.y;
        const float b1 = v1[e], b2 = v1[e + 8];
        v1[e] = b1 * c1.x - b2 * c1.y; v1[e + 8] = b2 * c1.x + b1 * c1.y;
      }
    } else if (branch == 1) {
#pragma unroll
      for (int e = 0; e < 16; ++e) {
        const int jf = crow(e, h);
        const float2 c = *(const float2*)(lds + tl * RROW + jf * 8);
        const float a1 = v0[e], a2 = v1[e];
        v0[e] = a1 * c.x - a2 * c.y; v1[e] = a2 * c.x + a1 * c.y;
      }
    }
    float sc = 1.f;
    if (kind == 0) sc = (branch == 3) ? (0.17677669529663687f * LOG2E) : (0.125f * LOG2E);
    bf16_t* dst;
    if (kind == 0) {
      const size_t qoff = (branch == 0) ? OFF_QA : (branch == 1) ? OFF_QB : (branch == 2) ? OFF_QC : OFF_QD;
      dst = (bf16_t*)(p.ws + qoff) + ((size_t)(b * 4 + head) * SEQ + s) * 64;
    } else {
      const size_t koff = (branch == 0) ? OFF_KA : (branch == 1) ? OFF_KB : (branch == 2) ? OFF_KC : OFF_KD;
      const int nh = (branch == 2) ? 4 : 2;
      dst = (bf16_t*)(p.ws + koff) + ((size_t)(b * nh + head) * SEQ + s) * 64;
    }
    dst += 4 * h;
#pragma unroll
    for (int g = 0; g < 4; ++g) {
      u32x2 o0, o1;
      o0[0] = pk2(v0[4 * g] * sc, v0[4 * g + 1] * sc); o0[1] = pk2(v0[4 * g + 2] * sc, v0[4 * g + 3] * sc);
      o1[0] = pk2(v1[4 * g] * sc, v1[4 * g + 1] * sc); o1[1] = pk2(v1[4 * g + 2] * sc, v1[4 * g + 3] * sc);
      *(u32x2*)(dst + 8 * g) = o0;
      *(u32x2*)(dst + 32 + 8 * g) = o1;
    }
  }
}

__device__ void outproj_tile(const Params& p, int l, int tile, char* lds, const float* __restrict__ xin, float* __restrict__ xout) {
  const int tid = opaque_tid(), w = tid >> 6, lane = tid & 63, r = lane & 31, h = lane >> 5;
  const int wm = w & 3, wn = w >> 2;
  const int nt = tile & 7, mt = tile >> 3;
  const int m0 = mt * 128, n0 = nt * 128;
  const bf16_t* Mx = (const bf16_t*)(p.ws + OFF_MIX);
  const bf16_t* Wt = (const bf16_t*)(p.ws + OFF_WOUT) + (size_t)l * 1024 * 1024;
  f32x16 acc[1][2];
  const __amdgpu_buffer_rsrc_t rsxin = mk_rsrc(xin);
  gemm_mainloop<false>(Mx, Wt, m0, n0, lds, acc);
#pragma unroll
  for (int i = 0; i < 1; ++i)
#pragma unroll
    for (int j = 0; j < 2; ++j) {
      const int n = n0 + 64 * wn + 32 * j + r;
#pragma unroll
      for (int e = 0; e < 16; ++e) {
        const int m = m0 + 32 * wm + crow(e, h);
        const size_t o = (size_t)m * DM + n;
        xout[o] = __uint_as_float(ld4(rsxin, o * 4)) + acc[i][j][e];
      }
    }
}

enum { MA = 0, MB = 1, MC = 2, MD = 3 };

template <int MODE>
__device__ void attn_item(const Params& p, int l, int item, char* lds) {
  const int tid = opaque_tid(), w = tid >> 6, lane = tid & 63, r = lane & 31, h = lane >> 5;
  const int qg = w & 3, role = w >> 2;
  constexpr int NKS = (MODE == MD) ? 2 : 4;
  constexpr bool FAST = (MODE == MA || MODE == MD);
  constexpr bool NEGM = FAST;
  constexpr float P_THR = 256.f;
  float* ldsR = (float*)(lds + 256 * LROW);

  int b, qtok, ktlo, kthi, head_out, koff = 0;
  const bf16_t *Qp, *Kg, *Vg;
  int qrow = 0, rs = 0, qcol0 = 0;
  if (MODE == MA || MODE == MB) {
    b = item >> 7; const int kvh = (item >> 6) & 1, qb = item & 63;
    qtok = qb * 128 + 32 * qg + r;
    head_out = kvh * 2 + role;
    Qp = (const bf16_t*)(p.ws + (MODE == MA ? OFF_QA : OFF_QB)) + ((size_t)(b * 4 + head_out) * SEQ + qtok) * 64 + 8 * h;
    const int kvrow = b * 2 + kvh;
    Kg = (const bf16_t*)(p.ws + (MODE == MA ? OFF_KA : OFF_KB)) + (size_t)kvrow * SEQ * 64;
    Vg = (const bf16_t*)(p.ws + (MODE == MA ? OFF_VA : OFF_VB)) + (size_t)kvrow * 64 * SEQ;
    if (MODE == MA) { ktlo = 0; kthi = 128; }
    else { ktlo = max(0, qb * 2 - 2); kthi = min(128, qb * 2 + 4); }
  } else if (MODE == MD) {
    b = item >> 8; const int hq = (item >> 6) & 3, qb = item & 63;
    qtok = qb * 128 + 32 * qg + r;
    head_out = hq;
    koff = 32 * role;
    Qp = (const bf16_t*)(p.ws + OFF_QD) + ((size_t)(b * 4 + hq) * SEQ + qtok) * 64 + koff + 8 * h;
    const int kvrow = b * 2 + (hq >> 1);
    Kg = (const bf16_t*)(p.ws + OFF_KD) + (size_t)kvrow * SEQ * 64;
    Vg = (const bf16_t*)(p.ws + OFF_VD) + (size_t)kvrow * 64 * SEQ;
    ktlo = 0; kthi = 128;
  } else {
    b = item >> 7; const int hh = (item >> 5) & 3, rg = item & 31;
    qrow = rg * 4 + qg;
    rs = min(max(qrow - 4, 0), 120);
    qcol0 = 32 * role;
    qtok = qrow * 64 + qcol0 + r;
    head_out = hh;
    Qp = (const bf16_t*)(p.ws + OFF_QC) + ((size_t)(b * 4 + hh) * SEQ + qtok) * 64 + 8 * h;
    const int kvrow = b * 4 + hh;
    Kg = (const bf16_t*)(p.ws + OFF_KC) + (size_t)kvrow * SEQ * 64;
    Vg = (const bf16_t*)(p.ws + OFF_VC) + (size_t)kvrow * 64 * SEQ;
    ktlo = min(max(rg * 4 - 4, 0), 120);
    kthi = min(max(rg * 4 + 3 - 4, 0), 120) + 8;
    const float* rp = p.rpb_c + ((size_t)l * 4 + hh) * 465;
    for (int i = tid; i < 465; i += 512) ldsR[i] = rp[i] * LOG2E;
  }

  const __amdgpu_buffer_rsrc_t rsw = mk_rsrc(p.ws);
  bf16x8 qf[NKS];
#pragma unroll
  for (int ks = 0; ks < NKS; ++ks) qf[ks] = __builtin_bit_cast(bf16x8, ld16(rsw, (size_t)((const char*)(Qp + 16 * ks) - p.ws)));

  f32x16 O[2];
#pragma unroll
  for (int db = 0; db < 2; ++db)
#pragma unroll
    for (int e = 0; e < 16; ++e) O[db][e] = 0.f;
  float mrun, lrun;
  if (MODE == MB) { mrun = p.sink_b[l * 4 + head_out] * LOG2E; lrun = 0.5f; }
  else { mrun = NEG; lrun = 0.f; }
  f32x16 negm;
  if (FAST) {
    f32x16 s0;
#pragma unroll
    for (int e = 0; e < 16; ++e) s0[e] = 0.f;
#pragma unroll
    for (int ks = 0; ks < NKS; ++ks) {
      const bf16_t* kp = Kg + ((size_t)ktlo * 64 + r) * 64 + koff + 16 * ks + 8 * h;
      const bf16x8 k0 = __builtin_bit_cast(bf16x8, ld16(rsw, (size_t)((const char*)kp - p.ws)));
      s0 = MFMA(k0, qf[ks], s0);
    }
    float m0 = s0[0];
#pragma unroll
    for (int e = 1; e < 16; ++e) m0 = fmaxf(m0, s0[e]);
    m0 = fmaxf(m0, xor32(m0));
    mrun = m0;
#pragma unroll
    for (int e = 0; e < 16; ++e) negm[e] = -m0;
  }
  u32x4 kreg, vreg;
  const int lrow = tid >> 3, lch = tid & 7;
  const bf16_t* kgp = Kg + (size_t)lrow * 64 + lch * 8;
  const bf16_t* vgp = Vg + (size_t)lrow * SEQ + lch * 8;
  kreg = ld16(rsw, (size_t)((const char*)(kgp + (size_t)ktlo * 64 * 64) - p.ws));
  vreg = ld16(rsw, (size_t)((const char*)(vgp + ktlo * 64) - p.ws));
  const int soff = lrow * LROW + lch * 16;
  const int vsoff = lrow * LROW + (lch >> 1) * 32 + (lch & 1) * 8;

  __syncthreads();
  *(u32x4*)(lds + soff) = kreg;
  { u32x2 lo_ = {vreg[0], vreg[1]}, hi_ = {vreg[2], vreg[3]}; *(u32x2*)(lds + 64 * LROW + vsoff) = lo_; *(u32x2*)(lds + 64 * LROW + vsoff + 16) = hi_; }
  if (ktlo + 1 < kthi) {
    kreg = ld16(rsw, (size_t)((const char*)(kgp + (size_t)(ktlo + 1) * 64 * 64) - p.ws));
    vreg = ld16(rsw, (size_t)((const char*)(vgp + (ktlo + 1) * 64) - p.ws));
  }
  __syncthreads();
  for (int kt = ktlo; kt < kthi; ++kt) {
    const int cur = (kt - ktlo) & 1;
    const char* ldsK = lds + cur * 128 * LROW;
    const char* ldsV = ldsK + 64 * LROW;
    if (kt + 1 < kthi) {
      char* nb = lds + (cur ^ 1) * 128 * LROW;
      *(u32x4*)(nb + soff) = kreg;
      { u32x2 lo_ = {vreg[0], vreg[1]}, hi_ = {vreg[2], vreg[3]}; *(u32x2*)(nb + 64 * LROW + vsoff) = lo_; *(u32x2*)(nb + 64 * LROW + vsoff + 16) = hi_; }
    }
    if (kt + 2 < kthi) {
      kreg = ld16(rsw, (size_t)((const char*)(kgp + (size_t)(kt + 2) * 64 * 64) - p.ws));
      vreg = ld16(rsw, (size_t)((const char*)(vgp + (kt + 2) * 64) - p.ws));
    }
    bool active = true;
    if (MODE == MC) active = (kt >= rs) && (kt < rs + 8);
    if (active) {
#pragma nounroll
      for (int kb = 0; kb < 2; ++kb) {
        bf16x8 pf[2];
        if (FAST) {
          f32x16 S = negm;
#pragma unroll
          for (int ks = 0; ks < NKS; ++ks) {
            const bf16x8 k0 = *(const bf16x8*)(ldsK + (32 * kb + r) * LROW + (koff + 16 * ks + 8 * h) * 2);
            S = MFMA(k0, qf[ks], S);
          }
          float ls = 0.f;
#pragma unroll
          for (int e = 0; e < 16; ++e) { S[e] = __builtin_amdgcn_exp2f(S[e]); ls += S[e]; }
          if (__any(!(ls <= P_THR))) {
            S = negm;
#pragma unroll
            for (int ks = 0; ks < NKS; ++ks) {
              const bf16x8 k0 = *(const bf16x8*)(ldsK + (32 * kb + r) * LROW + (koff + 16 * ks + 8 * h) * 2);
              S = MFMA(k0, qf[ks], S);
            }
            float mx = S[0];
#pragma unroll
            for (int e = 1; e < 16; ++e) mx = fmaxf(mx, S[e]);
            mx = fmaxf(mx, xor32(mx));
            const float d = fmaxf(mx, 0.f);
            const float alpha = __builtin_amdgcn_exp2f(-d);
            mrun += d;
            lrun *= alpha;
#pragma unroll
            for (int db = 0; db < 2; ++db)
#pragma unroll
              for (int e = 0; e < 16; ++e) O[db][e] *= alpha;
#pragma unroll
            for (int e = 0; e < 16; ++e) negm[e] -= d;
            ls = 0.f;
#pragma unroll
            for (int e = 0; e < 16; ++e) { S[e] = __builtin_amdgcn_exp2f(S[e] - d); ls += S[e]; }
          }
#pragma unroll
          for (int s = 0; s < 2; ++s) {
            u32x4 pk;
            pk[0] = pk2(S[8 * s + 0], S[8 * s + 1]); pk[1] = pk2(S[8 * s + 2], S[8 * s + 3]);
            pk[2] = pk2(S[8 * s + 4], S[8 * s + 5]); pk[3] = pk2(S[8 * s + 6], S[8 * s + 7]);
            pf[s] = __builtin_bit_cast(bf16x8, pk);
          }
          lrun += ls;
        } else {
          f32x16 S;
#pragma unroll
          for (int e = 0; e < 16; ++e) S[e] = 0.f;
#pragma unroll
          for (int ks = 0; ks < NKS; ++ks) {
            const bf16x8 k0 = *(const bf16x8*)(ldsK + (32 * kb + r) * LROW + (16 * ks + 8 * h) * 2);
            S = MFMA(k0, qf[ks], S);
          }
          if (MODE == MB) {
#pragma unroll
            for (int e = 0; e < 16; ++e) {
              const int kpos = kt * 64 + 32 * kb + crow(e, h);
              const int dlt = qtok - kpos;
              const bool ok = (dlt <= 128) && (dlt >= -128);
              S[e] = ok ? S[e] : NEG;
            }
          }
          if (MODE == MC) {
            const int dr = kt - qrow + 7;
            const int qcol = qcol0 + r;
            const int cs = min(max(qcol - 8, 0), 48);
#pragma unroll
            for (int e = 0; e < 16; ++e) {
              const int kcol = 32 * kb + crow(e, h);
              const bool ok = (kcol >= cs) && (kcol < cs + 16);
              const int dc = min(max(kcol - qcol, -15), 15) + 15;
              const float bias = ldsR[dr * 31 + dc];
              S[e] = ok ? (S[e] + bias) : NEG;
            }
          }
          float mx = S[0];
#pragma unroll
          for (int e = 1; e < 16; ++e) mx = fmaxf(mx, S[e]);
          mx = fmaxf(mx, xor32(mx));
          if (__any(mx > mrun)) {
            const float mn = fmaxf(mrun, mx);
            const float alpha = __builtin_amdgcn_exp2f(mrun - mn);
            mrun = mn;
            lrun *= alpha;
#pragma unroll
            for (int db = 0; db < 2; ++db)
#pragma unroll
              for (int e = 0; e < 16; ++e) O[db][e] *= alpha;
          }
          const float mn = mrun;
          float ls = 0.f;
#pragma unroll
          for (int e = 0; e < 16; ++e) {
            const float pvv = __builtin_amdgcn_exp2f(S[e] - mn);
            S[e] = pvv;
            ls += pvv;
          }
          lrun += ls;
#pragma unroll
          for (int s = 0; s < 2; ++s) {
            u32x4 pk;
            pk[0] = pk2(S[8 * s + 0], S[8 * s + 1]); pk[1] = pk2(S[8 * s + 2], S[8 * s + 3]);
            pk[2] = pk2(S[8 * s + 4], S[8 * s + 5]); pk[3] = pk2(S[8 * s + 6], S[8 * s + 7]);
            pf[s] = __builtin_bit_cast(bf16x8, pk);
          }
        }
#pragma unroll
        for (int s = 0; s < 2; ++s)
#pragma unroll
          for (int db = 0; db < 2; ++db) {
            const bf16x8 vf = *(const bf16x8*)(ldsV + (32 * db + r) * LROW + (32 * kb + 16 * s) * 2 + 16 * h);
            O[db] = MFMA(vf, pf[s], O[db]);
          }
      }
    }
    __syncthreads();
  }

  bf16_t* mix = (bf16_t*)(p.ws + OFF_MIX);
  lrun += xor32(lrun);
  const float inv = 1.f / lrun;
  if (MODE == MD) {
    float* xch = (float*)lds + (size_t)qg * 32 * 64 + lane;
    __syncthreads();
    if (role == 1) {
#pragma unroll
      for (int db = 0; db < 2; ++db)
#pragma unroll
        for (int e = 0; e < 16; ++e) xch[(db * 16 + e) * 64] = O[db][e] * inv;
    }
    __syncthreads();
    if (role == 1) return;
    const float lam = __uint_as_float(ld4(rsw, OFF_CTRL + (16 + l * 2 + 0) * 4)), omli = __uint_as_float(ld4(rsw, OFF_CTRL + (16 + l * 2 + 1) * 4));
    f32x16 o[2];
    float ss = 0.f;
#pragma unroll
    for (int db = 0; db < 2; ++db)
#pragma unroll
      for (int e = 0; e < 16; ++e) {
        const float t = O[db][e] * inv - lam * xch[(db * 16 + e) * 64];
        o[db][e] = t;
        ss += t * t;
      }
    ss += xor32(ss);
    const float rstd = rsqrtf(ss * (1.f / 64.f) + EPSV) * omli;
    const size_t base = (size_t)(b * SEQ + qtok) * 1024 + 768 + head_out * 64 + 4 * h;
    const float* sg = p.subln + l * 64 + 4 * h;
#pragma unroll
    for (int db = 0; db < 2; ++db)
#pragma unroll
      for (int g = 0; g < 4; ++g) {
        const size_t off = base + 32 * db + 8 * g;
        const u32x2 gv = ld8(rsw, OFF_GATE + off * 2);
        const float g0 = __uint_as_float(gv[0] << 16), g1 = __uint_as_float(gv[0] & 0xffff0000u);
        const float g2 = __uint_as_float(gv[1] << 16), g3 = __uint_as_float(gv[1] & 0xffff0000u);
        const float* sgp = sg + 32 * db + 8 * g;
        u32x2 ov;
        ov[0] = pk2(o[db][4 * g + 0] * rstd * sgp[0] * g0, o[db][4 * g + 1] * rstd * sgp[1] * g1);
        ov[1] = pk2(o[db][4 * g + 2] * rstd * sgp[2] * g2, o[db][4 * g + 3] * rstd * sgp[3] * g3);
        *(u32x2*)(mix + off) = ov;
      }
  } else {
    const int brc = (MODE == MA) ? 0 : (MODE == MB) ? 256 : 512;
    const size_t base = (size_t)(b * SEQ + qtok) * 1024 + brc + head_out * 64 + 4 * h;
#pragma unroll
    for (int db = 0; db < 2; ++db)
#pragma unroll
      for (int g = 0; g < 4; ++g) {
        const size_t off = base + 32 * db + 8 * g;
        const u32x2 gv = ld8(rsw, OFF_GATE + off * 2);
        const float g0 = __uint_as_float(gv[0] << 16), g1 = __uint_as_float(gv[0] & 0xffff0000u);
        const float g2 = __uint_as_float(gv[1] << 16), g3 = __uint_as_float(gv[1] & 0xffff0000u);
        u32x2 ov;
        ov[0] = pk2(O[db][4 * g + 0] * inv * g0, O[db][4 * g + 1] * inv * g1);
        ov[1] = pk2(O[db][4 * g + 2] * inv * g2, O[db][4 * g + 3] * inv * g3);
        *(u32x2*)(mix + off) = ov;
      }
  }
}

constexpr int N_D = 512, N_A = 256, N_B = 256, N_C = 256;
constexpr int N_ATT = N_D + N_A + N_B + N_C;

__device__ void phase_prep(const Params& p, char* lds) {
  const int tid = opaque_tid();
  const int gtid = blockIdx.x * blockDim.x + tid, nth = gridDim.x * blockDim.x;
  if (blockIdx.x == 0 && tid == 0) {
    float* cf = (float*)(p.ws + OFF_CTRL) + 16;
    for (int l = 0; l < 2; ++l) {
      float s1 = 0.f, s2 = 0.f;
      for (int i = 0; i < 32; ++i) { s1 += p.lq1[l * 32 + i] * p.lk1[l * 32 + i]; s2 += p.lq2[l * 32 + i] * p.lk2[l * 32 + i]; }
      const float li = (l == 0) ? 0.2f : 0.35550906759096934f;
      cf[l * 2 + 0] = __expf(s1) - __expf(s2) + li;
      cf[l * 2 + 1] = 1.0f - li;
    }
  }
  float2* T32 = (float2*)(p.ws + OFF_T32);
  for (int i = gtid; i < SEQ * 32; i += nth) {
    const int pos = i >> 5, j = i & 31;
    const float ang = (float)pos * INV32[j];
    float sn, cs;
    sincos_d(ang, sn, cs);
    T32[i] = make_float2(cs, sn);
  }
  const int half = tid >> 8, tl = tid & 255;
  for (int tp = blockIdx.x; tp < 832 + 256; tp += gridDim.x) {
    const int t = 2 * tp + half;
    const int l = t / 1088, tt = t % 1088;
    float* lf = (float*)(lds + half * 20480);
    if (tt < 832) wconv_tile(p.w_in + (size_t)l * 1024 * DIN, p.norm_g + l * 1024, (bf16_t*)(p.ws + OFF_WIN) + (size_t)l * DIN * 1024, DIN, tt, lf, tl);
    else wconv_tile(p.w_out + (size_t)l * 1024 * 1024, nullptr, (bf16_t*)(p.ws + OFF_WOUT) + (size_t)l * 1024 * 1024, 1024, tt - 832, lf, tl);
  }
  rms_rows<false>(p.x, (bf16_t*)(p.ws + OFF_H), nullptr, nullptr);
}

__device__ void phase_inproj(const Params& p, int l, char* lds) {
  for (int t = blockIdx.x; t < 128 * 26; t += gridDim.x) inproj_tile(p, l, t, lds);
}

DI int fetch_item(unsigned* ctr, int* s_item) {
  __syncthreads();
  if (threadIdx.x == 0) *s_item = (int)atomicAdd(ctr, 1u);
  __syncthreads();
  return *s_item;
}

__device__ void phase_attn(const Params& p, int l, char* lds, int* s_item, int cidx) {
  unsigned* ctr = (unsigned*)(p.ws + OFF_CTRL) + cidx;
  int item = blockIdx.x;
  while (item < N_A) { attn_item<MA>(p, l, item, lds); item = (int)gridDim.x + fetch_item(ctr, s_item); }
  while (item < N_A + N_D) { attn_item<MD>(p, l, item - N_A, lds); item = (int)gridDim.x + fetch_item(ctr, s_item); }
  while (item < N_A + N_D + N_B) { attn_item<MB>(p, l, item - N_A - N_D, lds); item = (int)gridDim.x + fetch_item(ctr, s_item); }
  while (item < N_ATT) { attn_item<MC>(p, l, item - N_A - N_D - N_B, lds); item = (int)gridDim.x + fetch_item(ctr, s_item); }
}

__device__ void phase_outproj(const Params& p, int l, char* lds) {
  const float* xin = (l == 0) ? p.x : (const float*)(p.ws + OFF_X1);
  float* xout = (l == 0) ? (float*)(p.ws + OFF_X1) : p.out;
  for (int t = blockIdx.x; t < 128 * 8; t += gridDim.x) outproj_tile(p, l, t, lds, xin, xout);
}

__global__ void __launch_bounds__(512, 4) fwd_megakernel(Params p) {
  __shared__ __attribute__((aligned(16))) char lds[4 * 128 * LROW];
  __shared__ int s_item;
  __shared__ uint4 xb_words;
  if (p.ws == nullptr) cg::this_grid().sync();
  if (threadIdx.x == 0) xb_words = make_uint4(0u, 0u, 0u, 0u);
  __syncthreads();
  XcdBarrier gb = xcd_barrier_post((unsigned*)(p.ws + OFF_BAR), (volatile LAS unsigned*)&xb_words);
  phase_prep(p, lds);
  xcd_barrier(gb);
  for (int l = 0; l < 2; ++l) {
    phase_inproj(p, l, lds);
    xcd_barrier(gb);
    phase_attn(p, l, lds, &s_item, l);
    xcd_barrier(gb);
#ifdef PROBE_ATTN2
    phase_attn(p, l, lds, &s_item, l + 2);
    xcd_barrier(gb);
#endif
#ifdef PROBE_GEMM2
    phase_inproj(p, l, lds);
    xcd_barrier(gb);
#endif
    phase_outproj(p, l, lds);
    xcd_barrier(gb);
    if (l == 0) {
      rms_rows<false>((const float*)(p.ws + OFF_X1), (bf16_t*)(p.ws + OFF_H), nullptr, nullptr);
      xcd_barrier(gb);
    } else {
      rms_rows<true>(p.out, nullptr, p.out, p.final_g);
    }
  }
}

extern "C" void kernel_launch(void* const* d_in, const int* in_sizes, int n_in, void* d_out,
                              int out_size, void* d_ws, size_t ws_size, hipStream_t stream) {
  static int grid_blocks = 0;
  if (!grid_blocks) {
    int dev = 0, cus = 0, per_cu = 0;
    (void)hipGetDevice(&dev);
    (void)hipDeviceGetAttribute(&cus, hipDeviceAttributeMultiprocessorCount, dev);
    (void)hipOccupancyMaxActiveBlocksPerMultiprocessor(&per_cu, fwd_megakernel, 512, 0);
    if (per_cu > 2) per_cu = 2;
    if (per_cu < 1) per_cu = 1;
    grid_blocks = cus * per_cu;
  }
  if (ws_size < WS_NEEDED) { fprintf(stderr, "workspace too small\n"); return; }
  Params p{};
  p.x = (const float*)d_in[0]; p.norm_g = (const float*)d_in[1]; p.w_in = (const float*)d_in[2]; p.w_out = (const float*)d_in[3];
  p.qn_a = (const float*)d_in[4]; p.kn_a = (const float*)d_in[5]; p.sink_b = (const float*)d_in[6]; p.rpb_c = (const float*)d_in[7];
  p.lq1 = (const float*)d_in[8]; p.lk1 = (const float*)d_in[9]; p.lq2 = (const float*)d_in[10]; p.lk2 = (const float*)d_in[11];
  p.subln = (const float*)d_in[12]; p.final_g = (const float*)d_in[13];
  p.out = (float*)d_out; p.ws = (char*)d_ws;
  (void)hipMemsetAsync(d_ws, 0, OFF_T32, stream);
  void* args[] = {&p};
  hipError_t e = hipLaunchCooperativeKernel((void*)fwd_megakernel, dim3(grid_blocks), dim3(512), args, 0, stream);
  if (e != hipSuccess) fprintf(stderr, "cooperative launch failed: %s (grid %d)\n", hipGetErrorString(e), grid_blocks);
}
```

```cpp
#include <hip/hip_runtime.h>
#include <hip/hip_cooperative_groups.h>
#include <cstdio>
#include <cstdint>
namespace cg = cooperative_groups;

#define DI __device__ __forceinline__
typedef unsigned short bf16_t;
typedef short bf16x8 __attribute__((ext_vector_type(8)));
typedef short s16x4 __attribute__((ext_vector_type(4)));
typedef float f32x16 __attribute__((ext_vector_type(16)));
typedef float f32x4 __attribute__((ext_vector_type(4)));
typedef float f32x2 __attribute__((ext_vector_type(2)));
typedef __bf16 bf16x2_t __attribute__((ext_vector_type(2)));
typedef unsigned u32x2 __attribute__((ext_vector_type(2)));
typedef unsigned u32x4 __attribute__((ext_vector_type(4)));

#define MFMA(a, b, c) __builtin_amdgcn_mfma_f32_32x32x16_bf16((a), (b), (c), 0, 0, 0)

constexpr int SEQ = 8192, DM = 1024, DIN = 3328, MTOK = 16384;
constexpr float LOG2E = 1.4426950408889634f;
constexpr float EPSV = 1e-6f;
constexpr float NEG = -1e30f;

constexpr size_t MiB = 1024 * 1024;
constexpr size_t OFF_BAR = 0;
constexpr size_t OFF_CTRL = 16384;
constexpr size_t OFF_T32 = 20480;
constexpr size_t OFF_WIN = OFF_T32 + 2 * MiB;
constexpr size_t OFF_WOUT = OFF_WIN + 13 * MiB;
constexpr size_t OFF_H = OFF_WOUT + 4 * MiB;
constexpr size_t OFF_QA = OFF_H + 32 * MiB;
constexpr size_t OFF_KA = OFF_QA + 8 * MiB;
constexpr size_t OFF_VA = OFF_KA + 4 * MiB;
constexpr size_t OFF_QB = OFF_VA + 4 * MiB;
constexpr size_t OFF_KB = OFF_QB + 8 * MiB;
constexpr size_t OFF_VB = OFF_KB + 4 * MiB;
constexpr size_t OFF_QC = OFF_VB + 4 * MiB;
constexpr size_t OFF_KC = OFF_QC + 8 * MiB;
constexpr size_t OFF_VC = OFF_KC + 8 * MiB;
constexpr size_t OFF_QD = OFF_VC + 8 * MiB;
constexpr size_t OFF_KD = OFF_QD + 8 * MiB;
constexpr size_t OFF_VD = OFF_KD + 4 * MiB;
constexpr size_t OFF_GATE = OFF_VD + 4 * MiB;
constexpr size_t OFF_X1 = OFF_GATE + 32 * MiB;
constexpr size_t OFF_MIX = OFF_X1 + 64 * MiB;
constexpr size_t WS_NEEDED = OFF_MIX + 32 * MiB;

struct Params {
  const float *x, *norm_g, *w_in, *w_out, *qn_a, *kn_a, *sink_b, *rpb_c, *lq1, *lk1, *lq2, *lk2, *subln, *final_g;
  float* out;
  char* ws;
};

__device__ const float INV32[32] = {
    1.000000000e+00f, 7.498942614e-01f, 5.623413324e-01f, 4.216965139e-01f, 3.162277639e-01f, 2.371373773e-01f,
    1.778279394e-01f, 1.333521307e-01f, 1.000000015e-01f, 7.498941571e-02f, 5.623413250e-02f, 4.216965288e-02f,
    3.162277490e-02f, 2.371373773e-02f, 1.778279431e-02f, 1.333521493e-02f, 9.999999776e-03f, 7.498941850e-03f,
    5.623413250e-03f, 4.216964822e-03f, 3.162277630e-03f, 2.371373586e-03f, 1.778279431e-03f, 1.333521446e-03f,
    1.000000047e-03f, 7.498942432e-04f, 5.623413017e-04f, 4.216965172e-04f, 3.162277571e-04f, 2.371373703e-04f,
    1.778279402e-04f, 1.333521504e-04f};

DI unsigned pk2(float a, float b) {
  f32x2 v = {a, b};
  return __builtin_bit_cast(unsigned, __builtin_convertvector(v, bf16x2_t));
}
DI float bf2f(unsigned short u) { return __uint_as_float(((unsigned)u) << 16); }
DI int crow(int reg, int h) { return (reg & 3) + 8 * (reg >> 2) + 4 * h; }
DI float xor32(float v) { return __shfl_xor(v, 32); }
DI __amdgpu_buffer_rsrc_t mk_rsrc(const void* base) { return __builtin_amdgcn_make_buffer_rsrc((void*)base, 0, 0x7fffffff, 0x00020000); }
DI u32x4 ld16(__amdgpu_buffer_rsrc_t rs, size_t byte_off) { return __builtin_amdgcn_raw_buffer_load_b128(rs, (int)(unsigned)byte_off, 0, 16); }
DI u32x2 ld8(__amdgpu_buffer_rsrc_t rs, size_t byte_off) { return __builtin_amdgcn_raw_buffer_load_b64(rs, (int)(unsigned)byte_off, 0, 16); }
DI unsigned ld4(__amdgpu_buffer_rsrc_t rs, size_t byte_off) { return __builtin_amdgcn_raw_buffer_load_b32(rs, (int)(unsigned)byte_off, 0, 16); }
DI int opaque_tid() { int t = threadIdx.x; asm volatile("" : "+v"(t)); return t; }


#define XB_TMO      128
#define XB_XCNT(j)  (256  + 64 * (j))
#define XB_XSUB(j)  (1280 + 64 * (j))
#define XB_XGEN(j)  (2304 + 64 * (j))
#define XB_TOP      3328
#define XB_TOPGEN   3392
#define XCD_BAR_WORDS 3456
#define XB_SPIN_CAP (1u << 20)
#define LAS __attribute__((address_space(3)))
DI unsigned xb_ld(unsigned* p) { return __hip_atomic_load(p, __ATOMIC_RELAXED, __HIP_MEMORY_SCOPE_AGENT); }
DI unsigned xb_add(unsigned* p, unsigned v) { return __hip_atomic_fetch_add(p, v, __ATOMIC_RELAXED, __HIP_MEMORY_SCOPE_AGENT); }
DI unsigned xb_xcc_id() { return (unsigned)__builtin_amdgcn_s_getreg((3 << 11) | 20) & 0xFu; }
#define XB_SPIN(cond, bar) do { unsigned _sp = 0; while (cond) { __builtin_amdgcn_s_sleep(1); \
    if ((++_sp & 255u) == 0u) { if (xb_ld(&(bar)[XB_TMO])) break; if (_sp > XB_SPIN_CAP) { atomicAdd(&(bar)[XB_TMO], 1u); break; } } } } while (0)
struct XcdBarrier { unsigned* bar; unsigned x; volatile LAS unsigned* st; };
DI XcdBarrier xcd_barrier_post(unsigned* bar, volatile LAS unsigned* st) {
  XcdBarrier b; b.bar = bar; b.x = xb_xcc_id(); b.st = st;
  if (threadIdx.x == 0) (void)xb_add(&bar[XB_XCNT(b.x)], 1u);
  return b;
}
DI void xcd_barrier_complete(unsigned* bar, unsigned x, unsigned& nloc, unsigned& nx) {
  const unsigned G = gridDim.x * gridDim.y * gridDim.z;
  unsigned sum, cnt, mine, sp = 0u;
  for (;;) {
    sum = 0u; cnt = 0u; mine = 0u;
#pragma unroll
    for (unsigned j = 0; j < 16; ++j) { const unsigned c = xb_ld(&bar[XB_XCNT(j)]); sum += c; cnt += (c > 0u) ? 1u : 0u; mine = (j == x) ? c : mine; }
    if (sum == G) break;
    __builtin_amdgcn_s_sleep(1);
    if ((++sp & 255u) == 0u) { if (xb_ld(&bar[XB_TMO])) break; if (sp > XB_SPIN_CAP) { atomicAdd(&bar[XB_TMO], 1u); break; } }
  }
  nloc = mine > 0u ? mine : 1u; nx = cnt > 0u ? cnt : 1u;
}
DI void xcd_barrier(const XcdBarrier& b) {
  asm volatile("s_waitcnt vmcnt(0)" ::: "memory");
  __syncthreads();
  if (threadIdx.x == 0) {
    unsigned* bar = b.bar;
    asm volatile("" : "+s"(bar));
    __builtin_amdgcn_s_waitcnt(0);
    unsigned nloc = b.st[0], nx = b.st[1];
    if (nloc == 0u) { xcd_barrier_complete(bar, b.x, nloc, nx); b.st[0] = nloc; b.st[1] = nx; }
    unsigned bx = b.x;
    asm volatile("" : "+s"(bx));
    const unsigned old = xb_add(&bar[XB_XSUB(bx)], 1u);
    const unsigned gen = old / nloc;
    if (old + 1u == (gen + 1u) * nloc) {
      __builtin_amdgcn_fence(__ATOMIC_RELEASE, "agent");
      asm volatile("s_waitcnt vmcnt(0)" ::: "memory");
      const unsigned og = xb_add(&bar[XB_TOP], 1u);
      const unsigned tg = og / nx;
      if (og + 1u == (tg + 1u) * nx) xb_add(&bar[XB_TOPGEN], 1u);
      else XB_SPIN(xb_ld(&bar[XB_TOPGEN]) == tg, bar);
      __builtin_amdgcn_fence(__ATOMIC_ACQUIRE, "agent");
      xb_add(&bar[XB_XGEN(bx)], 1u);
      asm volatile("s_waitcnt vmcnt(0)" ::: "memory");
    } else {
      XB_SPIN(xb_ld(&bar[XB_XGEN(bx)]) == gen, bar);
      __builtin_amdgcn_fence(__ATOMIC_ACQUIRE, "agent");
      asm volatile("s_waitcnt vmcnt(0)" ::: "memory");
    }
  }
  __syncthreads();
}

DI void sincos_d(float angf, float& sn, float& cs) {
  const double a = (double)angf;
  const double q = __builtin_rint(a * 0.63661977236758134308);
  double r = __builtin_fma(-q, 1.57079632679489655800e+00, a);
  r = __builtin_fma(-q, 6.12323399573676603587e-17, r);
  const int n = ((int)q) & 3;
  const double r2 = r * r;
  double sp = 1.0 / 6227020800.0;
  sp = sp * r2 - 1.0 / 39916800.0;
  sp = sp * r2 + 1.0 / 362880.0;
  sp = sp * r2 - 1.0 / 5040.0;
  sp = sp * r2 + 1.0 / 120.0;
  sp = sp * r2 - 1.0 / 6.0;
  sp = r + r * r2 * sp;
  double cp = -1.0 / 87178291200.0;
  cp = cp * r2 + 1.0 / 479001600.0;
  cp = cp * r2 - 1.0 / 3628800.0;
  cp = cp * r2 + 1.0 / 40320.0;
  cp = cp * r2 - 1.0 / 720.0;
  cp = cp * r2 + 1.0 / 24.0;
  cp = cp * r2 - 0.5;
  cp = 1.0 + r2 * cp;
  double s_, c_;
  if (n == 0) { s_ = sp; c_ = cp; }
  else if (n == 1) { s_ = cp; c_ = -sp; }
  else if (n == 2) { s_ = -sp; c_ = -cp; }
  else { s_ = -cp; c_ = sp; }
  sn = (float)s_; cs = (float)c_;
}

__device__ void wconv_tile(const float* __restrict__ W, const float* __restrict__ g, bf16_t* __restrict__ Wt, int N, int tile, float* lds, const int tid) {
  const int ntn = N >> 6;
  const int k0 = (tile / ntn) << 6, n0 = (tile % ntn) << 6;
  __syncthreads();
#pragma unroll
  for (int i = 0; i < 16; ++i) {
    const int k = i * 4 + (tid >> 6), n = tid & 63;
    float v = W[(size_t)(k0 + k) * N + n0 + n];
    if (g) v *= g[k0 + k];
    lds[k * 65 + n] = v;
  }
  __syncthreads();
#pragma unroll
  for (int i = 0; i < 16; ++i) {
    const int n = i * 4 + (tid >> 6), k = tid & 63;
    Wt[(size_t)(n0 + n) * 1024 + k0 + k] = (bf16_t)(pk2(lds[k * 65 + n], 0.f) & 0xffffu);
  }
}

template <bool FINAL>
__device__ void rms_rows(const float* X, bf16_t* H, float* O, const float* g) {
  const int t_ = opaque_tid();
  const int lane = t_ & 63;
  const int gw = (blockIdx.x * blockDim.x + t_) >> 6, nw = (gridDim.x * blockDim.x) >> 6;
  const __amdgpu_buffer_rsrc_t rsx = mk_rsrc(X);
  const __amdgpu_buffer_rsrc_t rso = mk_rsrc(FINAL ? (const void*)O : (const void*)X);
  for (int row = gw; row < MTOK; row += nw) {
    f32x4 v[4];
    float ss = 0.f;
#pragma unroll
    for (int i = 0; i < 4; ++i) {
      v[i] = __builtin_bit_cast(f32x4, ld16(rsx, ((size_t)row * DM + i * 256 + lane * 4) * 4));
      ss += v[i][0] * v[i][0] + v[i][1] * v[i][1] + v[i][2] * v[i][2] + v[i][3] * v[i][3];
    }
#pragma unroll
    for (int o = 32; o >= 1; o >>= 1) ss += __shfl_xor(ss, o);
    const float rstd = rsqrtf(ss * (1.0f / DM) + EPSV);
#pragma unroll
    for (int i = 0; i < 4; ++i) {
      if (FINAL) {
        const f32x4 gg = *(const f32x4*)(g + i * 256 + lane * 4);
        f32x4 o = v[i] * rstd * gg;
        __builtin_amdgcn_raw_buffer_store_b128(__builtin_bit_cast(u32x4, o), rso, (int)(unsigned)(((size_t)row * DM + i * 256 + lane * 4) * 4), 0, 16);
      } else {
        u32x2 o;
        o[0] = pk2(v[i][0] * rstd, v[i][1] * rstd);
        o[1] = pk2(v[i][2] * rstd, v[i][3] * rstd);
        *(u32x2*)(H + (size_t)row * DM + i * 256 + lane * 4) = o;
      }
    }
  }
}

constexpr int LROW = 144;
template <bool SWAP>
DI void gemm_mainloop(const bf16_t* __restrict__ A, const bf16_t* __restrict__ Bm, int m0, int n0, char* lds, f32x16 (&acc)[1][2]) {
  const int tid = opaque_tid(), w = tid >> 6, lane = tid & 63, r = lane & 31, h = lane >> 5;
  const int wm = w & 3, wn = w >> 2;
#pragma unroll
  for (int j = 0; j < 2; ++j)
#pragma unroll
    for (int e = 0; e < 16; ++e) acc[0][j][e] = 0.f;
  u32x4 ra[2], rb[2];
  const __amdgpu_buffer_rsrc_t rsa = mk_rsrc(A), rsb = mk_rsrc(Bm);
  const unsigned oa = (unsigned)(((size_t)(m0 + (tid >> 3)) * 1024 + (tid & 7) * 8) * 2);
  const unsigned ob = (unsigned)(((size_t)(n0 + (tid >> 3)) * 1024 + (tid & 7) * 8) * 2);
#pragma unroll
  for (int i = 0; i < 2; ++i) {
    ra[i] = ld16(rsa, oa + i * 64 * 2048);
    rb[i] = ld16(rsb, ob + i * 64 * 2048);
  }
  const int soff = (tid >> 3) * LROW + (tid & 7) * 16;
  __syncthreads();
#pragma unroll
  for (int i = 0; i < 2; ++i) {
    *(u32x4*)(lds + soff + i * 64 * LROW) = ra[i];
    *(u32x4*)(lds + 128 * LROW + soff + i * 64 * LROW) = rb[i];
  }
#pragma unroll
  for (int i = 0; i < 2; ++i) {
    ra[i] = ld16(rsa, oa + i * 64 * 2048 + 128);
    rb[i] = ld16(rsb, ob + i * 64 * 2048 + 128);
  }
  __syncthreads();
  for (int kt = 0; kt < 16; ++kt) {
    const char* ldsA = lds + (kt & 1) * 256 * LROW;
    const char* ldsB = ldsA + 128 * LROW;
    char* nb = lds + ((kt + 1) & 1) * 256 * LROW;
    const bool st = (kt + 1 < 16), ldn = (kt + 2 < 16);
#pragma unroll
    for (int ks = 0; ks < 4; ++ks) {
      const bf16x8 af = *(const bf16x8*)(ldsA + (32 * wm + r) * LROW + (16 * ks + 8 * h) * 2);
      bf16x8 bfr[2];
#pragma unroll
      for (int j = 0; j < 2; ++j) bfr[j] = *(const bf16x8*)(ldsB + (64 * wn + 32 * j + r) * LROW + (16 * ks + 8 * h) * 2);
#pragma unroll
      for (int j = 0; j < 2; ++j) {
        if (SWAP) acc[0][j] = MFMA(bfr[j], af, acc[0][j]);
        else acc[0][j] = MFMA(af, bfr[j], acc[0][j]);
      }
      const int i = ks >> 1;
      if ((ks & 1) == 0) {
        if (st) *(u32x4*)(nb + soff + i * 64 * LROW) = ra[i];
        if (ldn) ra[i] = ld16(rsa, oa + i * 64 * 2048 + (kt + 2) * 128);
      } else {
        if (st) *(u32x4*)(nb + 128 * LROW + soff + i * 64 * LROW) = rb[i];
        if (ldn) rb[i] = ld16(rsb, ob + i * 64 * 2048 + (kt + 2) * 128);
      }
      __builtin_amdgcn_sched_barrier(0);
    }
    __syncthreads();
  }
}

__device__ void inproj_tile(const Params& p, int l, int tile, char* lds) {
  const int tid = opaque_tid(), w = tid >> 6, lane = tid & 63, r = lane & 31, h = lane >> 5;
  const int wm = w & 3, wn = w >> 2;
  const int nt = tile % 26, mt = tile / 26;
  const int m0 = mt * 128, n0 = nt * 128;
  const bf16_t* Hb = (const bf16_t*)(p.ws + OFF_H);
  const bf16_t* Wt = (const bf16_t*)(p.ws + OFF_WIN) + (size_t)l * DIN * 1024;
  const bool isV = (nt == 3) || (nt == 9) || (nt == 16) || (nt == 17) || (nt == 23);
  const int hc = (n0 >> 6) + wn;
  f32x16 acc[1][2];
  if (isV) {
    gemm_mainloop<false>(Hb, Wt, m0, n0, lds, acc);
    bf16_t* dst; int nh, vh;
    if (hc < 8) { dst = (bf16_t*)(p.ws + OFF_VA); nh = 2; vh = hc - 6; }
    else if (hc < 20) { dst = (bf16_t*)(p.ws + OFF_VB); nh = 2; vh = hc - 18; }
    else if (hc < 36) { dst = (bf16_t*)(p.ws + OFF_VC); nh = 4; vh = hc - 32; }
    else { dst = (bf16_t*)(p.ws + OFF_VD); nh = 2; vh = hc - 46; }
    const int b = m0 >> 13, s0 = (m0 & 8191) + 32 * wm;
#pragma unroll
    for (int i = 0; i < 1; ++i)
#pragma unroll
      for (int j = 0; j < 2; ++j) {
        const int d = 32 * j + r;
        bf16_t* row = dst + ((size_t)(b * nh + vh) * 64 + d) * SEQ + s0 + 32 * i + 4 * h;
#pragma unroll
        for (int g = 0; g < 4; ++g) {
          u32x2 o;
          o[0] = pk2(acc[i][j][4 * g + 0], acc[i][j][4 * g + 1]);
          o[1] = pk2(acc[i][j][4 * g + 2], acc[i][j][4 * g + 3]);
          *(u32x2*)(row + 8 * g) = o;
        }
      }
    return;
  }
  gemm_mainloop<true>(Hb, Wt, m0, n0, lds, acc);
  int branch, idx;
  if (hc < 12) { branch = 0; idx = hc; }
  else if (hc < 24) { branch = 1; idx = hc - 12; }
  else if (hc < 40) { branch = 2; idx = hc - 24; }
  else { branch = 3; idx = hc - 40; }
  int kind, head;
  if (branch == 2) {
    if (idx < 4) { kind = 0; head = idx; } else if (idx < 8) { kind = 1; head = idx - 4; } else { kind = 3; head = idx - 12; }
  } else {
    if (idx < 4) { kind = 0; head = idx; } else if (idx < 6) { kind = 1; head = idx - 4; } else { kind = 3; head = idx - 8; }
  }
  constexpr int RROW = 272;
  const bool needs_rope = (kind != 3) && (branch != 2);
  if (needs_rope) {
    const int s0 = m0 & 8191;
    const __amdgpu_buffer_rsrc_t rst = mk_rsrc(p.ws + OFF_T32);
    if (branch == 0) {
      for (int idx = tid; idx < 66 * 16; idx += 512) {
        const int row = idx >> 4, c = idx & 15;
        const int pos = row < 64 ? row : (s0 >> 6) + (row - 64);
        *(u32x4*)(lds + row * RROW + c * 16) = ld16(rst, (size_t)(pos * 16 + c) * 16);
      }
      if (tid < 64) ((float*)(lds + 66 * RROW))[tid] = (kind == 0 ? p.qn_a : p.kn_a)[l * 64 + tid];
    } else {
      for (int idx = tid; idx < 128 * 16; idx += 512) {
        const int row = idx >> 4, c = idx & 15;
        *(u32x4*)(lds + row * RROW + c * 16) = ld16(rst, (size_t)((s0 + row) * 16 + c) * 16);
      }
    }
    __syncthreads();
  }
  const float* gl = (const float*)(lds + 66 * RROW);
#pragma unroll
  for (int i = 0; i < 1; ++i) {
    const int token = m0 + 32 * wm + r;
    const int tl = 32 * wm + r;
    const int b = token >> 13, s = token & 8191;
    f32x16 v0 = acc[i][0], v1 = acc[i][1];
    if (kind == 3) {
      bf16_t* dst = (bf16_t*)(p.ws + OFF_GATE) + (size_t)token * 1024 + branch * 256 + head * 64 + 4 * h;
#pragma unroll
      for (int g = 0; g < 4; ++g) {
        float t[8];
#pragma unroll
        for (int e = 0; e < 4; ++e) {
          const float a0 = v0[4 * g + e], a1 = v1[4 * g + e];
          t[e] = a0 * __builtin_amdgcn_rcpf(1.f + __builtin_amdgcn_exp2f(-a0 * LOG2E));
          t[4 + e] = a1 * __builtin_amdgcn_rcpf(1.f + __builtin_amdgcn_exp2f(-a1 * LOG2E));
        }
        u32x2 o0, o1;
        o0[0] = pk2(t[0], t[1]); o0[1] = pk2(t[2], t[3]);
        o1[0] = pk2(t[4], t[5]); o1[1] = pk2(t[6], t[7]);
        *(u32x2*)(dst + 8 * g) = o0;
        *(u32x2*)(dst + 32 + 8 * g) = o1;
      }
      continue;
    }
    if (branch == 0) {
      float ss = 0.f;
#pragma unroll
      for (int e = 0; e < 16; ++e) ss += v0[e] * v0[e] + v1[e] * v1[e];
      ss += xor32(ss);
      const float rstd = rsqrtf(ss * (1.f / 64.f) + EPSV);
#pragma unroll
      for (int e = 0; e < 16; ++e) {
        v0[e] = v0[e] * rstd * gl[crow(e, h)];
        v1[e] = v1[e] * rstd * gl[32 + crow(e, h)];
      }
    }
    if (branch == 0 || branch == 3) {
      const int row0 = (branch == 0) ? (64 + (tl >> 6)) : tl;
      const int row1 = (branch == 0) ? (tl & 63) : tl;
#pragma unroll
      for (int e = 0; e < 8; ++e) {
        const int jf = crow(e, h);
        const float2 c0 = *(const float2*)(lds + row0 * RROW + jf * 16);
        const float2 c1 = *(const float2*)(lds + row1 * RROW + jf * 16);
        const float a1 = v0[e], a2 = v0[e + 8];
        v0[e] = a1 * c0.x - a2 * c0.y; v0[e + 8] = a2 * c0.x + a1 * c0.y;
        const float b1 = v1[e], b2 = v1[e + 8];
        v1[e] = b1 * c1.x - b2 * c1.y; v1[e + 8] = b2 * c1.x + b1 * c1.y;
      }
    } else if (branch == 1) {
#pragma unroll
      for (int e = 0; e < 16; ++e) {
        const int jf = crow(e, h);
        const float2 c = *(const float2*)(lds + tl * RROW + jf * 8);
        const float a1 = v0[e], a2 = v1[e];
        v0[e] = a1 * c.x - a2 * c.y; v1[e] = a2 * c.x + a1 * c.y;
      }
    }
    float sc = 1.f;
    if (kind == 0) sc = (branch == 3) ? (0.17677669529663687f * LOG2E) : (0.125f * LOG2E);
    bf16_t* dst;
    if (kind == 0) {
      const size_t qoff = (branch == 0) ? OFF_QA : (branch == 1) ? OFF_QB : (branch == 2) ? OFF_QC : OFF_QD;
      dst = (bf16_t*)(p.ws + qoff) + ((size_t)(b * 4 + head) * SEQ + s) * 64;
    } else {
      const size_t koff = (branch == 0) ? OFF_KA : (branch == 1) ? OFF_KB : (branch == 2) ? OFF_KC : OFF_KD;
      const int nh = (branch == 2) ? 4 : 2;
      dst = (bf16_t*)(p.ws + koff) + ((size_t)(b * nh + head) * SEQ + s) * 64;
    }
    dst += 4 * h;
#pragma unroll
    for (int g = 0; g < 4; ++g) {
      u32x2 o0, o1;
      o0[0] = pk2(v0[4 * g] * sc, v0[4 * g + 1] * sc); o0[1] = pk2(v0[4 * g + 2] * sc, v0[4 * g + 3] * sc);
      o1[0] = pk2(v1[4 * g] * sc, v1[4 * g + 1] * sc); o1[1] = pk2(v1[4 * g + 2] * sc, v1[4 * g + 3] * sc);
      *(u32x2*)(dst + 8 * g) = o0;
      *(u32x2*)(dst + 32 + 8 * g) = o1;
    }
  }
}

__device__ void outproj_tile(const Params& p, int l, int tile, char* lds, const float* __restrict__ xin, float* __restrict__ xout) {
  const int tid = opaque_tid(), w = tid >> 6, lane = tid & 63, r = lane & 31, h = lane >> 5;
  const int wm = w & 3, wn = w >> 2;
  const int nt = tile & 7, mt = tile >> 3;
  const int m0 = mt * 128, n0 = nt * 128;
  const bf16_t* Mx = (const bf16_t*)(p.ws + OFF_MIX);
  const bf16_t* Wt = (const bf16_t*)(p.ws + OFF_WOUT) + (size_t)l * 1024 * 1024;
  f32x16 acc[1][2];
  const __amdgpu_buffer_rsrc_t rsxin = mk_rsrc(xin);
  gemm_mainloop<false>(Mx, Wt, m0, n0, lds, acc);
#pragma unroll
  for (int i = 0; i < 1; ++i)
#pragma unroll
    for (int j = 0; j < 2; ++j) {
      const int n = n0 + 64 * wn + 32 * j + r;
#pragma unroll
      for (int e = 0; e < 16; ++e) {
        const int m = m0 + 32 * wm + crow(e, h);
        const size_t o = (size_t)m * DM + n;
        xout[o] = __uint_as_float(ld4(rsxin, o * 4)) + acc[i][j][e];
      }
    }
}

enum { MA = 0, MB = 1, MC = 2, MD = 3 };

template <int MODE>
__device__ void attn_item(const Params& p, int l, int item, char* lds) {
  const int tid = opaque_tid(), w = tid >> 6, lane = tid & 63, r = lane & 31, h = lane >> 5;
  const int qg = w & 3, role = w >> 2;
  constexpr int NKS = (MODE == MD) ? 2 : 4;
  constexpr bool FAST = (MODE == MA || MODE == MD);
  constexpr bool NEGM = FAST;
  constexpr float P_THR = 256.f;
  float* ldsR = (float*)(lds + 256 * LROW);

  int b, qtok, ktlo, kthi, head_out, koff = 0;
  const bf16_t *Qp, *Kg, *Vg;
  int qrow = 0, rs = 0, qcol0 = 0;
  if (MODE == MA || MODE == MB) {
    b = item >> 7; const int kvh = (item >> 6) & 1, qb = item & 63;
    qtok = qb * 128 + 32 * qg + r;
    head_out = kvh * 2 + role;
    Qp = (const bf16_t*)(p.ws + (MODE == MA ? OFF_QA : OFF_QB)) + ((size_t)(b * 4 + head_out) * SEQ + qtok) * 64 + 8 * h;
    const int kvrow = b * 2 + kvh;
    Kg = (const bf16_t*)(p.ws + (MODE == MA ? OFF_KA : OFF_KB)) + (size_t)kvrow * SEQ * 64;
    Vg = (const bf16_t*)(p.ws + (MODE == MA ? OFF_VA : OFF_VB)) + (size_t)kvrow * 64 * SEQ;
    if (MODE == MA) { ktlo = 0; kthi = 128; }
    else { ktlo = max(0, qb * 2 - 2); kthi = min(128, qb * 2 + 4); }
  } else if (MODE == MD) {
    b = item >> 8; const int hq = (item >> 6) & 3, qb = item & 63;
    qtok = qb * 128 + 32 * qg + r;
    head_out = hq;
    koff = 32 * role;
    Qp = (const bf16_t*)(p.ws + OFF_QD) + ((size_t)(b * 4 + hq) * SEQ + qtok) * 64 + koff + 8 * h;
    const int kvrow = b * 2 + (hq >> 1);
    Kg = (const bf16_t*)(p.ws + OFF_KD) + (size_t)kvrow * SEQ * 64;
    Vg = (const bf16_t*)(p.ws + OFF_VD) + (size_t)kvrow * 64 * SEQ;
    ktlo = 0; kthi = 128;
  } else {
    b = item >> 7; const int hh = (item >> 5) & 3, rg = item & 31;
    qrow = rg * 4 + qg;
    rs = min(max(qrow - 4, 0), 120);
    qcol0 = 32 * role;
    qtok = qrow * 64 + qcol0 + r;
    head_out = hh;
    Qp = (const bf16_t*)(p.ws + OFF_QC) + ((size_t)(b * 4 + hh) * SEQ + qtok) * 64 + 8 * h;
    const int kvrow = b * 4 + hh;
    Kg = (const bf16_t*)(p.ws + OFF_KC) + (size_t)kvrow * SEQ * 64;
    Vg = (const bf16_t*)(p.ws + OFF_VC) + (size_t)kvrow * 64 * SEQ;
    ktlo = min(max(rg * 4 - 4, 0), 120);
    kthi = min(max(rg * 4 + 3 - 4, 0), 120) + 8;
    const float* rp = p.rpb_c + ((size_t)l * 4 + hh) * 465;
    for (int i = tid; i < 465; i += 512) ldsR[i] = rp[i] * LOG2E;
  }

  const __amdgpu_buffer_rsrc_t rsw = mk_rsrc(p.ws);
  bf16x8 qf[NKS];
#pragma unroll
  for (int ks = 0; ks < NKS; ++ks) qf[ks] = __builtin_bit_cast(bf16x8, ld16(rsw, (size_t)((const char*)(Qp + 16 * ks) - p.ws)));

  f32x16 O[2];
#pragma unroll
  for (int db = 0; db < 2; ++db)
#pragma unroll
    for (int e = 0; e < 16; ++e) O[db][e] = 0.f;
  float mrun, lrun;
  if (MODE == MB) { mrun = p.sink_b[l * 4 + head_out] * LOG2E; lrun = 0.5f; }
  else { mrun = NEG; lrun = 0.f; }
  f32x16 negm;
  if (FAST) {
    f32x16 s0;
#pragma unroll
    for (int e = 0; e < 16; ++e) s0[e] = 0.f;
#pragma unroll
    for (int ks = 0; ks < NKS; ++ks) {
      const bf16_t* kp = Kg + ((size_t)ktlo * 64 + r) * 64 + koff + 16 * ks + 8 * h;
      const bf16x8 k0 = __builtin_bit_cast(bf16x8, ld16(rsw, (size_t)((const char*)kp - p.ws)));
      s0 = MFMA(k0, qf[ks], s0);
    }
    float m0 = s0[0];
#pragma unroll
    for (int e = 1; e < 16; ++e) m0 = fmaxf(m0, s0[e]);
    m0 = fmaxf(m0, xor32(m0));
    mrun = m0;
#pragma unroll
    for (int e = 0; e < 16; ++e) negm[e] = -m0;
  }
  u32x4 kreg, vreg;
  const int lrow = tid >> 3, lch = tid & 7;
  const bf16_t* kgp = Kg + (size_t)lrow * 64 + lch * 8;
  const bf16_t* vgp = Vg + (size_t)lrow * SEQ + lch * 8;
  kreg = ld16(rsw, (size_t)((const char*)(kgp + (size_t)ktlo * 64 * 64) - p.ws));
  vreg = ld16(rsw, (size_t)((const char*)(vgp + ktlo * 64) - p.ws));
  const int soff = lrow * LROW + lch * 16;
  const int vsoff = lrow * LROW + (lch >> 1) * 32 + (lch & 1) * 8;

  __syncthreads();
  *(u32x4*)(lds + soff) = kreg;
  { u32x2 lo_ = {vreg[0], vreg[1]}, hi_ = {vreg[2], vreg[3]}; *(u32x2*)(lds + 64 * LROW + vsoff) = lo_; *(u32x2*)(lds + 64 * LROW + vsoff + 16) = hi_; }
  if (ktlo + 1 < kthi) {
    kreg = ld16(rsw, (size_t)((const char*)(kgp + (size_t)(ktlo + 1) * 64 * 64) - p.ws));
    vreg = ld16(rsw, (size_t)((const char*)(vgp + (ktlo + 1) * 64) - p.ws));
  }
  __syncthreads();
  for (int kt = ktlo; kt < kthi; ++kt) {
    const int cur = (kt - ktlo) & 1;
    const char* ldsK = lds + cur * 128 * LROW;
    const char* ldsV = ldsK + 64 * LROW;
    if (kt + 1 < kthi) {
      char* nb = lds + (cur ^ 1) * 128 * LROW;
      *(u32x4*)(nb + soff) = kreg;
      { u32x2 lo_ = {vreg[0], vreg[1]}, hi_ = {vreg[2], vreg[3]}; *(u32x2*)(nb + 64 * LROW + vsoff) = lo_; *(u32x2*)(nb + 64 * LROW + vsoff + 16) = hi_; }
    }
    if (kt + 2 < kthi) {
      kreg = ld16(rsw, (size_t)((const char*)(kgp + (size_t)(kt + 2) * 64 * 64) - p.ws));
      vreg = ld16(rsw, (size_t)((const char*)(vgp + (kt + 2) * 64) - p.ws));
    }
    bool active = true;
    if (MODE == MC) active = (kt >= rs) && (kt < rs + 8);
    if (active) {
#pragma nounroll
      for (int kb = 0; kb < 2; ++kb) {
        bf16x8 pf[2];
        if (FAST) {
          f32x16 S = negm;
#pragma unroll
          for (int ks = 0; ks < NKS; ++ks) {
            const bf16x8 k0 = *(const bf16x8*)(ldsK + (32 * kb + r) * LROW + (koff + 16 * ks + 8 * h) * 2);
            S = MFMA(k0, qf[ks], S);
          }
          float ls = 0.f;
#pragma unroll
          for (int e = 0; e < 16; ++e) { S[e] = __builtin_amdgcn_exp2f(S[e]); ls += S[e]; }
          if (__any(!(ls <= P_THR))) {
            S = negm;
#pragma unroll
            for (int ks = 0; ks < NKS; ++ks) {
              const bf16x8 k0 = *(const bf16x8*)(ldsK + (32 * kb + r) * LROW + (koff + 16 * ks + 8 * h) * 2);
              S = MFMA(k0, qf[ks], S);
            }
            float mx = S[0];
#pragma unroll
            for (int e = 1; e < 16; ++e) mx = fmaxf(mx, S[e]);
            mx = fmaxf(mx, xor32(mx));
            const float d = fmaxf(mx, 0.f);
            const float alpha = __builtin_amdgcn_exp2f(-d);
            mrun += d;
            lrun *= alpha;
#pragma unroll
            for (int db = 0; db < 2; ++db)
#pragma unroll
              for (int e = 0; e < 16; ++e) O[db][e] *= alpha;
#pragma unroll
            for (int e = 0; e < 16; ++e) negm[e] -= d;
            ls = 0.f;
#pragma unroll
            for (int e = 0; e < 16; ++e) { S[e] = __builtin_amdgcn_exp2f(S[e] - d); ls += S[e]; }
          }
#pragma unroll
          for (int s = 0; s < 2; ++s) {
            u32x4 pk;
            pk[0] = pk2(S[8 * s + 0], S[8 * s + 1]); pk[1] = pk2(S[8 * s + 2], S[8 * s + 3]);
            pk[2] = pk2(S[8 * s + 4], S[8 * s + 5]); pk[3] = pk2(S[8 * s + 6], S[8 * s + 7]);
            pf[s] = __builtin_bit_cast(bf16x8, pk);
          }
          lrun += ls;
        } else {
          f32x16 S;
#pragma unroll
          for (int e = 0; e < 16; ++e) S[e] = 0.f;
#pragma unroll
          for (int ks = 0; ks < NKS; ++ks) {
            const bf16x8 k0 = *(const bf16x8*)(ldsK + (32 * kb + r) * LROW + (16 * ks + 8 * h) * 2);
            S = MFMA(k0, qf[ks], S);
          }
          if (MODE == MB) {
#pragma unroll
            for (int e = 0; e < 16; ++e) {
              const int kpos = kt * 64 + 32 * kb + crow(e, h);
              const int dlt = qtok - kpos;
              const bool ok = (dlt <= 128) && (dlt >= -128);
              S[e] = ok ? S[e] : NEG;
            }
          }
          if (MODE == MC) {
            const int dr = kt - qrow + 7;
            const int qcol = qcol0 + r;
            const int cs = min(max(qcol - 8, 0), 48);
#pragma unroll
            for (int e = 0; e < 16; ++e) {
              const int kcol = 32 * kb + crow(e, h);
              const bool ok = (kcol >= cs) && (kcol < cs + 16);
              const int dc = min(max(kcol - qcol, -15), 15) + 15;
              const float bias = ldsR[dr * 31 + dc];
              S[e] = ok ? (S[e] + bias) : NEG;
            }
          }
          float mx = S[0];
#pragma unroll
          for (int e = 1; e < 16; ++e) mx = fmaxf(mx, S[e]);
          mx = fmaxf(mx, xor32(mx));
          if (__any(mx > mrun)) {
            const float mn = fmaxf(mrun, mx);
            const float alpha = __builtin_amdgcn_exp2f(mrun - mn);
            mrun = mn;
            lrun *= alpha;
#pragma unroll
            for (int db = 0; db < 2; ++db)
#pragma unroll
              for (int e = 0; e < 16; ++e) O[db][e] *= alpha;
          }
          const float mn = mrun;
          float ls = 0.f;
#pragma unroll
          for (int e = 0; e < 16; ++e) {
            const float pvv = __builtin_amdgcn_exp2f(S[e] - mn);
            S[e] = pvv;
            ls += pvv;
          }
          lrun += ls;
#pragma unroll
          for (int s = 0; s < 2; ++s) {
            u32x4 pk;
            pk[0] = pk2(S[8 * s + 0], S[8 * s + 1]); pk[1] = pk2(S[8 * s + 2], S[8 * s + 3]);
            pk[2] = pk2(S[8 * s + 4], S[8 * s + 5]); pk[3] = pk2(S[8 * s + 6], S[8 * s + 7]);
            pf[s] = __builtin_bit_cast(bf16x8, pk);
          }
        }
#pragma unroll
        for (int s = 0; s < 2; ++s)
#pragma unroll
          for (int db = 0; db < 2; ++db) {
            const bf16x8 vf = *(const bf16x8*)(ldsV + (32 * db + r) * LROW + (32 * kb + 16 * s) * 2 + 16 * h);
            O[db] = MFMA(vf, pf[s], O[db]);
          }
      }
    }
    __syncthreads();
  }

  bf16_t* mix = (bf16_t*)(p.ws + OFF_MIX);
  lrun += xor32(lrun);
  const float inv = 1.f / lrun;
  if (MODE == MD) {
    float* xch = (float*)lds + (size_t)qg * 32 * 64 + lane;
    __syncthreads();
    if (role == 1) {
#pragma unroll
      for (int db = 0; db < 2; ++db)
#pragma unroll
        for (int e = 0; e < 16; ++e) xch[(db * 16 + e) * 64] = O[db][e] * inv;
    }
    __syncthreads();
    if (role == 1) return;
    const float lam = __uint_as_float(ld4(rsw, OFF_CTRL + (16 + l * 2 + 0) * 4)), omli = __uint_as_float(ld4(rsw, OFF_CTRL + (16 + l * 2 + 1) * 4));
    f32x16 o[2];
    float ss = 0.f;
#pragma unroll
    for (int db = 0; db < 2; ++db)
#pragma unroll
      for (int e = 0; e < 16; ++e) {
        const float t = O[db][e] * inv - lam * xch[(db * 16 + e) * 64];
        o[db][e] = t;
        ss += t * t;
      }
    ss += xor32(ss);
    const float rstd = rsqrtf(ss * (1.f / 64.f) + EPSV) * omli;
    const size_t base = (size_t)(b * SEQ + qtok) * 1024 + 768 + head_out * 64 + 4 * h;
    const float* sg = p.subln + l * 64 + 4 * h;
#pragma unroll
    for (int db = 0; db < 2; ++db)
#pragma unroll
      for (int g = 0; g < 4; ++g) {
        const size_t off = base + 32 * db + 8 * g;
        const u32x2 gv = ld8(rsw, OFF_GATE + off * 2);
        const float g0 = __uint_as_float(gv[0] << 16), g1 = __uint_as_float(gv[0] & 0xffff0000u);
        const float g2 = __uint_as_float(gv[1] << 16), g3 = __uint_as_float(gv[1] & 0xffff0000u);
        const float* sgp = sg + 32 * db + 8 * g;
        u32x2 ov;
        ov[0] = pk2(o[db][4 * g + 0] * rstd * sgp[0] * g0, o[db][4 * g + 1] * rstd * sgp[1] * g1);
        ov[1] = pk2(o[db][4 * g + 2] * rstd * sgp[2] * g2, o[db][4 * g + 3] * rstd * sgp[3] * g3);
        *(u32x2*)(mix + off) = ov;
      }
  } else {
    const int brc = (MODE == MA) ? 0 : (MODE == MB) ? 256 : 512;
    const size_t base = (size_t)(b * SEQ + qtok) * 1024 + brc + head_out * 64 + 4 * h;
#pragma unroll
    for (int db = 0; db < 2; ++db)
#pragma unroll
      for (int g = 0; g < 4; ++g) {
        const size_t off = base + 32 * db + 8 * g;
        const u32x2 gv = ld8(rsw, OFF_GATE + off * 2);
        const float g0 = __uint_as_float(gv[0] << 16), g1 = __uint_as_float(gv[0] & 0xffff0000u);
        const float g2 = __uint_as_float(gv[1] << 16), g3 = __uint_as_float(gv[1] & 0xffff0000u);
        u32x2 ov;
        ov[0] = pk2(O[db][4 * g + 0] * inv * g0, O[db][4 * g + 1] * inv * g1);
        ov[1] = pk2(O[db][4 * g + 2] * inv * g2, O[db][4 * g + 3] * inv * g3);
        *(u32x2*)(mix + off) = ov;
      }
  }
}

constexpr int N_D = 512, N_A = 256, N_B = 256, N_C = 256;
constexpr int N_ATT = N_D + N_A + N_B + N_C;

__device__ void phase_prep(const Params& p, char* lds) {
  const int tid = opaque_tid();
  const int gtid = blockIdx.x * blockDim.x + tid, nth = gridDim.x * blockDim.x;
  if (blockIdx.x == 0 && tid == 0) {
    float* cf = (float*)(p.ws + OFF_CTRL) + 16;
    for (int l = 0; l < 2; ++l) {
      float s1 = 0.f, s2 = 0.f;
      for (int i = 0; i < 32; ++i) { s1 += p.lq1[l * 32 + i] * p.lk1[l * 32 + i]; s2 += p.lq2[l * 32 + i] * p.lk2[l * 32 + i]; }
      const float li = (l == 0) ? 0.2f : 0.35550906759096934f;
      cf[l * 2 + 0] = __expf(s1) - __expf(s2) + li;
      cf[l * 2 + 1] = 1.0f - li;
    }
  }
  float2* T32 = (float2*)(p.ws + OFF_T32);
  for (int i = gtid; i < SEQ * 32; i += nth) {
    const int pos = i >> 5, j = i & 31;
    const float ang = (float)pos * INV32[j];
    float sn, cs;
    sincos_d(ang, sn, cs);
    T32[i] = make_float2(cs, sn);
  }
  const int half = tid >> 8, tl = tid & 255;
  for (int tp = blockIdx.x; tp < 832 + 256; tp += gridDim.x) {
    const int t = 2 * tp + half;
    const int l = t / 1088, tt = t % 1088;
    float* lf = (float*)(lds + half * 20480);
    if (tt < 832) wconv_tile(p.w_in + (size_t)l * 1024 * DIN, p.norm_g + l * 1024, (bf16_t*)(p.ws + OFF_WIN) + (size_t)l * DIN * 1024, DIN, tt, lf, tl);
    else wconv_tile(p.w_out + (size_t)l * 1024 * 1024, nullptr, (bf16_t*)(p.ws + OFF_WOUT) + (size_t)l * 1024 * 1024, 1024, tt - 832, lf, tl);
  }
  rms_rows<false>(p.x, (bf16_t*)(p.ws + OFF_H), nullptr, nullptr);
}

__device__ void phase_inproj(const Params& p, int l, char* lds) {
  for (int t = blockIdx.x; t < 128 * 26; t += gridDim.x) inproj_tile(p, l, t, lds);
}

DI int fetch_item(unsigned* ctr, int* s_item) {
  __syncthreads();
  if (threadIdx.x == 0) *s_item = (int)atomicAdd(ctr, 1u);
  __syncthreads();
  return *s_item;
}

__device__ void phase_attn(const Params& p, int l, char* lds, int* s_item, int cidx) {
  unsigned* ctr = (unsigned*)(p.ws + OFF_CTRL) + cidx;
  int item = blockIdx.x;
  while (item < N_A) { attn_item<MA>(p, l, item, lds); item = (int)gridDim.x + fetch_item(ctr, s_item); }
  while (item < N_A + N_D) { attn_item<MD>(p, l, item - N_A, lds); item = (int)gridDim.x + fetch_item(ctr, s_item); }
  while (item < N_A + N_D + N_B) { attn_item<MB>(p, l, item - N_A - N_D, lds); item = (int)gridDim.x + fetch_item(ctr, s_item); }
  while (item < N_ATT) { attn_item<MC>(p, l, item - N_A - N_D - N_B, lds); item = (int)gridDim.x + fetch_item(ctr, s_item); }
}

__device__ void phase_outproj(const Params& p, int l, char* lds) {
  const float* xin = (l == 0) ? p.x : (const float*)(p.ws + OFF_X1);
  float* xout = (l == 0) ? (float*)(p.ws + OFF_X1) : p.out;
  for (int t = blockIdx.x; t < 128 * 8; t += gridDim.x) outproj_tile(p, l, t, lds, xin, xout);
}

__global__ void __launch_bounds__(512, 4) fwd_megakernel(Params p) {
  __shared__ __attribute__((aligned(16))) char lds[4 * 128 * LROW];
  __shared__ int s_item;
  __shared__ uint4 xb_words;
  if (p.ws == nullptr) cg::this_grid().sync();
  if (threadIdx.x == 0) xb_words = make_uint4(0u, 0u, 0u, 0u);
  __syncthreads();
  XcdBarrier gb = xcd_barrier_post((unsigned*)(p.ws + OFF_BAR), (volatile LAS unsigned*)&xb_words);
  phase_prep(p, lds);
  xcd_barrier(gb);
  for (int l = 0; l < 2; ++l) {
    phase_inproj(p, l, lds);
    xcd_barrier(gb);
    phase_attn(p, l, lds, &s_item, l);
    xcd_barrier(gb);
#ifdef PROBE_ATTN2
    phase_attn(p, l, lds, &s_item, l + 2);
    xcd_barrier(gb);
#endif
#ifdef PROBE_GEMM2
    phase_inproj(p, l, lds);
    xcd_barrier(gb);
#endif
    phase_outproj(p, l, lds);
    xcd_barrier(gb);
    if (l == 0) {
      rms_rows<false>((const float*)(p.ws + OFF_X1), (bf16_t*)(p.ws + OFF_H), nullptr, nullptr);
      xcd_barrier(gb);
    } else {
      rms_rows<true>(p.out, nullptr, p.out, p.final_g);
    }
  }
}

extern "C" void kernel_launch(void* const* d_in, const int* in_sizes, int n_in, void* d_out,
                              int out_size, void* d_ws, size_t ws_size, hipStream_t stream) {
  static int grid_blocks = 0;
  if (!grid_blocks) {
    int dev = 0, cus = 0, per_cu = 0;
    (void)hipGetDevice(&dev);
    (void)hipDeviceGetAttribute(&cus, hipDeviceAttributeMultiprocessorCount, dev);
    (void)hipOccupancyMaxActiveBlocksPerMultiprocessor(&per_cu, fwd_megakernel, 512, 0);
    if (per_cu > 2) per_cu = 2;
    if (per_cu < 1) per_cu = 1;
    grid_blocks = cus * per_cu;
  }
  if (ws_size < WS_NEEDED) { fprintf(stderr, "workspace too small\n"); return; }
  Params p{};
  p.x = (const float*)d_in[0]; p.norm_g = (const float*)d_in[1]; p.w_in = (const float*)d_in[2]; p.w_out = (const float*)d_in[3];
  p.qn_a = (const float*)d_in[4]; p.kn_a = (const float*)d_in[5]; p.sink_b = (const float*)d_in[6]; p.rpb_c = (const float*)d_in[7];
  p.lq1 = (const float*)d_in[8]; p.lk1 = (const float*)d_in[9]; p.lq2 = (const float*)d_in[10]; p.lk2 = (const float*)d_in[11];
  p.subln = (const float*)d_in[12]; p.final_g = (const float*)d_in[13];
  p.out = (float*)d_out; p.ws = (char*)d_ws;
  (void)hipMemsetAsync(d_ws, 0, OFF_T32, stream);
  void* args[] = {&p};
  hipError_t e = hipLaunchCooperativeKernel((void*)fwd_megakernel, dim3(grid_blocks), dim3(512), args, 0, stream);
  if (e != hipSuccess) fprintf(stderr, "cooperative launch failed: %s (grid %d)\n", hipGetErrorString(e), grid_blocks);
}
```

```cpp
#include <hip/hip_runtime.h>
#include <hip/hip_cooperative_groups.h>
#include <cstdio>
#include <cstdint>
namespace cg = cooperative_groups;

#define DI __device__ __forceinline__
typedef unsigned short bf16_t;
typedef short bf16x8 __attribute__((ext_vector_type(8)));
typedef short s16x4 __attribute__((ext_vector_type(4)));
typedef float f32x16 __attribute__((ext_vector_type(16)));
typedef float f32x4 __attribute__((ext_vector_type(4)));
typedef float f32x2 __attribute__((ext_vector_type(2)));
typedef __bf16 bf16x2_t __attribute__((ext_vector_type(2)));
typedef unsigned u32x2 __attribute__((ext_vector_type(2)));
typedef unsigned u32x4 __attribute__((ext_vector_type(4)));

#define MFMA(a, b, c) __builtin_amdgcn_mfma_f32_32x32x16_bf16((a), (b), (c), 0, 0, 0)

constexpr int SEQ = 8192, DM = 1024, DIN = 3328, MTOK = 16384;
constexpr float LOG2E = 1.4426950408889634f;
constexpr float EPSV = 1e-6f;
constexpr float NEG = -1e30f;

constexpr size_t MiB = 1024 * 1024;
constexpr size_t OFF_BAR = 0;
constexpr size_t OFF_CTRL = 16384;
constexpr size_t OFF_T32 = 20480;
constexpr size_t OFF_WIN = OFF_T32 + 2 * MiB;
constexpr size_t OFF_WOUT = OFF_WIN + 13 * MiB;
constexpr size_t OFF_H = OFF_WOUT + 4 * MiB;
constexpr size_t OFF_QA = OFF_H + 32 * MiB;
constexpr size_t OFF_KA = OFF_QA + 8 * MiB;
constexpr size_t OFF_VA = OFF_KA + 4 * MiB;
constexpr size_t OFF_QB = OFF_VA + 4 * MiB;
constexpr size_t OFF_KB = OFF_QB + 8 * MiB;
constexpr size_t OFF_VB = OFF_KB + 4 * MiB;
constexpr size_t OFF_QC = OFF_VB + 4 * MiB;
constexpr size_t OFF_KC = OFF_QC + 8 * MiB;
constexpr size_t OFF_VC = OFF_KC + 8 * MiB;
constexpr size_t OFF_QD = OFF_VC + 8 * MiB;
constexpr size_t OFF_KD = OFF_QD + 8 * MiB;
constexpr size_t OFF_VD = OFF_KD + 4 * MiB;
constexpr size_t OFF_GATE = OFF_VD + 4 * MiB;
constexpr size_t OFF_X1 = OFF_GATE + 32 * MiB;
constexpr size_t OFF_MIX = OFF_X1 + 64 * MiB;
constexpr size_t WS_NEEDED = OFF_MIX + 32 * MiB;

struct Params {
  const float *x, *norm_g, *w_in, *w_out, *qn_a, *kn_a, *sink_b, *rpb_c, *lq1, *lk1, *lq2, *lk2, *subln, *final_g;
  float* out;
  char* ws;
};

__device__ const float INV32[32] = {
    1.000000000e+00f, 7.498942614e-01f, 5.623413324e-01f, 4.216965139e-01f, 3.162277639e-01f, 2.371373773e-01f,
    1.778279394e-01f, 1.333521307e-01f, 1.000000015e-01f, 7.498941571e-02f, 5.623413250e-02f, 4.216965288e-02f,
    3.162277490e-02f, 2.371373773e-02f, 1.778279431e-02f, 1.333521493e-02f, 9.999999776e-03f, 7.498941850e-03f,
    5.623413250e-03f, 4.216964822e-03f, 3.162277630e-03f, 2.371373586e-03f, 1.778279431e-03f, 1.333521446e-03f,
    1.000000047e-03f, 7.498942432e-04f, 5.623413017e-04f, 4.216965172e-04f, 3.162277571e-04f, 2.371373703e-04f,
    1.778279402e-04f, 1.333521504e-04f};

DI unsigned pk2(float a, float b) {
  f32x2 v = {a, b};
  return __builtin_bit_cast(unsigned, __builtin_convertvector(v, bf16x2_t));
}
DI float bf2f(unsigned short u) { return __uint_as_float(((unsigned)u) << 16); }
DI int crow(int reg, int h) { return (reg & 3) + 8 * (reg >> 2) + 4 * h; }
DI float xor32(float v) { return __shfl_xor(v, 32); }
DI __amdgpu_buffer_rsrc_t mk_rsrc(const void* base) { return __builtin_amdgcn_make_buffer_rsrc((void*)base, 0, 0x7fffffff, 0x00020000); }
DI u32x4 ld16(__amdgpu_buffer_rsrc_t rs, size_t byte_off) { return __builtin_amdgcn_raw_buffer_load_b128(rs, (int)(unsigned)byte_off, 0, 16); }
DI u32x2 ld8(__amdgpu_buffer_rsrc_t rs, size_t byte_off) { return __builtin_amdgcn_raw_buffer_load_b64(rs, (int)(unsigned)byte_off, 0, 16); }
DI unsigned ld4(__amdgpu_buffer_rsrc_t rs, size_t byte_off) { return __builtin_amdgcn_raw_buffer_load_b32(rs, (int)(unsigned)byte_off, 0, 16); }
DI int opaque_tid() { int t = threadIdx.x; asm volatile("" : "+v"(t)); return t; }


#define XB_TMO      128
#define XB_XCNT(j)  (256  + 64 * (j))
#define XB_XSUB(j)  (1280 + 64 * (j))
#define XB_XGEN(j)  (2304 + 64 * (j))
#define XB_TOP      3328
#define XB_TOPGEN   3392
#define XCD_BAR_WORDS 3456
#define XB_SPIN_CAP (1u << 20)
#define LAS __attribute__((address_space(3)))
DI unsigned xb_ld(unsigned* p) { return __hip_atomic_load(p, __ATOMIC_RELAXED, __HIP_MEMORY_SCOPE_AGENT); }
DI unsigned xb_add(unsigned* p, unsigned v) { return __hip_atomic_fetch_add(p, v, __ATOMIC_RELAXED, __HIP_MEMORY_SCOPE_AGENT); }
DI unsigned xb_xcc_id() { return (unsigned)__builtin_amdgcn_s_getreg((3 << 11) | 20) & 0xFu; }
#define XB_SPIN(cond, bar) do { unsigned _sp = 0; while (cond) { __builtin_amdgcn_s_sleep(1); \
    if ((++_sp & 255u) == 0u) { if (xb_ld(&(bar)[XB_TMO])) break; if (_sp > XB_SPIN_CAP) { atomicAdd(&(bar)[XB_TMO], 1u); break; } } } } while (0)
struct XcdBarrier { unsigned* bar; unsigned x; volatile LAS unsigned* st; };
DI XcdBarrier xcd_barrier_post(unsigned* bar, volatile LAS unsigned* st) {
  XcdBarrier b; b.bar = bar; b.x = xb_xcc_id(); b.st = st;
  if (threadIdx.x == 0) (void)xb_add(&bar[XB_XCNT(b.x)], 1u);
  return b;
}
DI void xcd_barrier_complete(unsigned* bar, unsigned x, unsigned& nloc, unsigned& nx) {
  const unsigned G = gridDim.x * gridDim.y * gridDim.z;
  unsigned sum, cnt, mine, sp = 0u;
  for (;;) {
    sum = 0u; cnt = 0u; mine = 0u;
#pragma unroll
    for (unsigned j = 0; j < 16; ++j) { const unsigned c = xb_ld(&bar[XB_XCNT(j)]); sum += c; cnt += (c > 0u) ? 1u : 0u; mine = (j == x) ? c : mine; }
    if (sum == G) break;
    __builtin_amdgcn_s_sleep(1);
    if ((++sp & 255u) == 0u) { if (xb_ld(&bar[XB_TMO])) break; if (sp > XB_SPIN_CAP) { atomicAdd(&bar[XB_TMO], 1u); break; } }
  }
  nloc = mine > 0u ? mine : 1u; nx = cnt > 0u ? cnt : 1u;
}
DI void xcd_barrier(const XcdBarrier& b) {
  asm volatile("s_waitcnt vmcnt(0)" ::: "memory");
  __syncthreads();
  if (threadIdx.x == 0) {
    unsigned* bar = b.bar;
    asm volatile("" : "+s"(bar));
    __builtin_amdgcn_s_waitcnt(0);
    unsigned nloc = b.st[0], nx = b.st[1];
    if (nloc == 0u) { xcd_barrier_complete(bar, b.x, nloc, nx); b.st[0] = nloc; b.st[1] = nx; }
    unsigned bx = b.x;
    asm volatile("" : "+s"(bx));
    const unsigned old = xb_add(&bar[XB_XSUB(bx)], 1u);
    const unsigned gen = old / nloc;
    if (old + 1u == (gen + 1u) * nloc) {
      __builtin_amdgcn_fence(__ATOMIC_RELEASE, "agent");
      asm volatile("s_waitcnt vmcnt(0)" ::: "memory");
      const unsigned og = xb_add(&bar[XB_TOP], 1u);
      const unsigned tg = og / nx;
      if (og + 1u == (tg + 1u) * nx) xb_add(&bar[XB_TOPGEN], 1u);
      else XB_SPIN(xb_ld(&bar[XB_TOPGEN]) == tg, bar);
      __builtin_amdgcn_fence(__ATOMIC_ACQUIRE, "agent");
      xb_add(&bar[XB_XGEN(bx)], 1u);
      asm volatile("s_waitcnt vmcnt(0)" ::: "memory");
    } else {
      XB_SPIN(xb_ld(&bar[XB_XGEN(bx)]) == gen, bar);
      __builtin_amdgcn_fence(__ATOMIC_ACQUIRE, "agent");
      asm volatile("s_waitcnt vmcnt(0)" ::: "memory");
    }
  }
  __syncthreads();
}

DI void sincos_d(float angf, float& sn, float& cs) {
  const double a = (double)angf;
  const double q = __builtin_rint(a * 0.63661977236758134308);
  double r = __builtin_fma(-q, 1.57079632679489655800e+00, a);
  r = __builtin_fma(-q, 6.12323399573676603587e-17, r);
  const int n = ((int)q) & 3;
  const double r2 = r * r;
  double sp = 1.0 / 6227020800.0;
  sp = sp * r2 - 1.0 / 39916800.0;
  sp = sp * r2 + 1.0 / 362880.0;
  sp = sp * r2 - 1.0 / 5040.0;
  sp = sp * r2 + 1.0 / 120.0;
  sp = sp * r2 - 1.0 / 6.0;
  sp = r + r * r2 * sp;
  double cp = -1.0 / 87178291200.0;
  cp = cp * r2 + 1.0 / 479001600.0;
  cp = cp * r2 - 1.0 / 3628800.0;
  cp = cp * r2 + 1.0 / 40320.0;
  cp = cp * r2 - 1.0 / 720.0;
  cp = cp * r2 + 1.0 / 24.0;
  cp = cp * r2 - 0.5;
  cp = 1.0 + r2 * cp;
  double s_, c_;
  if (n == 0) { s_ = sp; c_ = cp; }
  else if (n == 1) { s_ = cp; c_ = -sp; }
  else if (n == 2) { s_ = -sp; c_ = -cp; }
  else { s_ = -cp; c_ = sp; }
  sn = (float)s_; cs = (float)c_;
}

__device__ void wconv_tile(const float* __restrict__ W, const float* __restrict__ g, bf16_t* __restrict__ Wt, int N, int tile, float* lds, const int tid) {
  const int ntn = N >> 6;
  const int k0 = (tile / ntn) << 6, n0 = (tile % ntn) << 6;
  __syncthreads();
#pragma unroll
  for (int i = 0; i < 16; ++i) {
    const int k = i * 4 + (tid >> 6), n = tid & 63;
    float v = W[(size_t)(k0 + k) * N + n0 + n];
    if (g) v *= g[k0 + k];
    lds[k * 65 + n] = v;
  }
  __syncthreads();
#pragma unroll
  for (int i = 0; i < 16; ++i) {
    const int n = i * 4 + (tid >> 6), k = tid & 63;
    Wt[(size_t)(n0 + n) * 1024 + k0 + k] = (bf16_t)(pk2(lds[k * 65 + n], 0.f) & 0xffffu);
  }
}

template <bool FINAL>
__device__ void rms_rows(const float* X, bf16_t* H, float* O, const float* g) {
  const int t_ = opaque_tid();
  const int lane = t_ & 63;
  const int gw = (blockIdx.x * blockDim.x + t_) >> 6, nw = (gridDim.x * blockDim.x) >> 6;
  const __amdgpu_buffer_rsrc_t rsx = mk_rsrc(X);
  const __amdgpu_buffer_rsrc_t rso = mk_rsrc(FINAL ? (const void*)O : (const void*)X);
  for (int row = gw; row < MTOK; row += nw) {
    f32x4 v[4];
    float ss = 0.f;
#pragma unroll
    for (int i = 0; i < 4; ++i) {
      v[i] = __builtin_bit_cast(f32x4, ld16(rsx, ((size_t)row * DM + i * 256 + lane * 4) * 4));
      ss += v[i][0] * v[i][0] + v[i][1] * v[i][1] + v[i][2] * v[i][2] + v[i][3] * v[i][3];
    }
#pragma unroll
    for (int o = 32; o >= 1; o >>= 1) ss += __shfl_xor(ss, o);
    const float rstd = rsqrtf(ss * (1.0f / DM) + EPSV);
#pragma unroll
    for (int i = 0; i < 4; ++i) {
      if (FINAL) {
        const f32x4 gg = *(const f32x4*)(g + i * 256 + lane * 4);
        f32x4 o = v[i] * rstd * gg;
        __builtin_amdgcn_raw_buffer_store_b128(__builtin_bit_cast(u32x4, o), rso, (int)(unsigned)(((size_t)row * DM + i * 256 + lane * 4) * 4), 0, 16);
      } else {
        u32x2 o;
        o[0] = pk2(v[i][0] * rstd, v[i][1] * rstd);
        o[1] = pk2(v[i][2] * rstd, v[i][3] * rstd);
        *(u32x2*)(H + (size_t)row * DM + i * 256 + lane * 4) = o;
      }
    }
  }
}

constexpr int LROW = 144;
template <bool SWAP>
DI void gemm_mainloop(const bf16_t* __restrict__ A, const bf16_t* __restrict__ Bm, int m0, int n0, char* lds, f32x16 (&acc)[1][2]) {
  const int tid = opaque_tid(), w = tid >> 6, lane = tid & 63, r = lane & 31, h = lane >> 5;
  const int wm = w & 3, wn = w >> 2;
#pragma unroll
  for (int j = 0; j < 2; ++j)
#pragma unroll
    for (int e = 0; e < 16; ++e) acc[0][j][e] = 0.f;
  u32x4 ra[2], rb[2];
  const __amdgpu_buffer_rsrc_t rsa = mk_rsrc(A), rsb = mk_rsrc(Bm);
  const unsigned oa = (unsigned)(((size_t)(m0 + (tid >> 3)) * 1024 + (tid & 7) * 8) * 2);
  const unsigned ob = (unsigned)(((size_t)(n0 + (tid >> 3)) * 1024 + (tid & 7) * 8) * 2);
#pragma unroll
  for (int i = 0; i < 2; ++i) {
    ra[i] = ld16(rsa, oa + i * 64 * 2048);
    rb[i] = ld16(rsb, ob + i * 64 * 2048);
  }
  const int soff = (tid >> 3) * LROW + (tid & 7) * 16;
  __syncthreads();
#pragma unroll
  for (int i = 0; i < 2; ++i) {
    *(u32x4*)(lds + soff + i * 64 * LROW) = ra[i];
    *(u32x4*)(lds + 128 * LROW + soff + i * 64 * LROW) = rb[i];
  }
#pragma unroll
  for (int i = 0; i < 2; ++i) {
    ra[i] = ld16(rsa, oa + i * 64 * 2048 + 128);
    rb[i] = ld16(rsb, ob + i * 64 * 2048 + 128);
  }
  __syncthreads();
  for (int kt = 0; kt < 16; ++kt) {
    const char* ldsA = lds + (kt & 1) * 256 * LROW;
    const char* ldsB = ldsA + 128 * LROW;
    char* nb = lds + ((kt + 1) & 1) * 256 * LROW;
    const bool st = (kt + 1 < 16), ldn = (kt + 2 < 16);
#pragma unroll
    for (int ks = 0; ks < 4; ++ks) {
      const bf16x8 af = *(const bf16x8*)(ldsA + (32 * wm + r) * LROW + (16 * ks + 8 * h) * 2);
      bf16x8 bfr[2];
#pragma unroll
      for (int j = 0; j < 2; ++j) bfr[j] = *(const bf16x8*)(ldsB + (64 * wn + 32 * j + r) * LROW + (16 * ks + 8 * h) * 2);
#pragma unroll
      for (int j = 0; j < 2; ++j) {
        if (SWAP) acc[0][j] = MFMA(bfr[j], af, acc[0][j]);
        else acc[0][j] = MFMA(af, bfr[j], acc[0][j]);
      }
      const int i = ks >> 1;
      if ((ks & 1) == 0) {
        if (st) *(u32x4*)(nb + soff + i * 64 * LROW) = ra[i];
        if (ldn) ra[i] = ld16(rsa, oa + i * 64 * 2048 + (kt + 2) * 128);
      } else {
        if (st) *(u32x4*)(nb + 128 * LROW + soff + i * 64 * LROW) = rb[i];
        if (ldn) rb[i] = ld16(rsb, ob + i * 64 * 2048 + (kt + 2) * 128);
      }
      __builtin_amdgcn_sched_barrier(0);
    }
    __syncthreads();
  }
}

__device__ void inproj_tile(const Params& p, int l, int tile, char* lds) {
  const int tid = opaque_tid(), w = tid >> 6, lane = tid & 63, r = lane & 31, h = lane >> 5;
  const int wm = w & 3, wn = w >> 2;
  const int nt = tile % 26, mt = tile / 26;
  const int m0 = mt * 128, n0 = nt * 128;
  const bf16_t* Hb = (const bf16_t*)(p.ws + OFF_H);
  const bf16_t* Wt = (const bf16_t*)(p.ws + OFF_WIN) + (size_t)l * DIN * 1024;
  const bool isV = (nt == 3) || (nt == 9) || (nt == 16) || (nt == 17) || (nt == 23);
  const int hc = (n0 >> 6) + wn;
  f32x16 acc[1][2];
  if (isV) {
    gemm_mainloop<false>(Hb, Wt, m0, n0, lds, acc);
    bf16_t* dst; int nh, vh;
    if (hc < 8) { dst = (bf16_t*)(p.ws + OFF_VA); nh = 2; vh = hc - 6; }
    else if (hc < 20) { dst = (bf16_t*)(p.ws + OFF_VB); nh = 2; vh = hc - 18; }
    else if (hc < 36) { dst = (bf16_t*)(p.ws + OFF_VC); nh = 4; vh = hc - 32; }
    else { dst = (bf16_t*)(p.ws + OFF_VD); nh = 2; vh = hc - 46; }
    const int b = m0 >> 13, s0 = (m0 & 8191) + 32 * wm;
#pragma unroll
    for (int i = 0; i < 1; ++i)
#pragma unroll
      for (int j = 0; j < 2; ++j) {
        const int d = 32 * j + r;
        bf16_t* row = dst + ((size_t)(b * nh + vh) * 64 + d) * SEQ + s0 + 32 * i + 4 * h;
#pragma unroll
        for (int g = 0; g < 4; ++g) {
          u32x2 o;
          o[0] = pk2(acc[i][j][4 * g + 0], acc[i][j][4 * g + 1]);
          o[1] = pk2(acc[i][j][4 * g + 2], acc[i][j][4 * g + 3]);
          *(u32x2*)(row + 8 * g) = o;
        }
      }
    return;
  }
  gemm_mainloop<true>(Hb, Wt, m0, n0, lds, acc);
  int branch, idx;
  if (hc < 12) { branch = 0; idx = hc; }
  else if (hc < 24) { branch = 1; idx = hc - 12; }
  else if (hc < 40) { branch = 2; idx = hc - 24; }
  else { branch = 3; idx = hc - 40; }
  int kind, head;
  if (branch == 2) {
    if (idx < 4) { kind = 0; head = idx; } else if (idx < 8) { kind = 1; head = idx - 4; } else { kind = 3; head = idx - 12; }
  } else {
    if (idx < 4) { kind = 0; head = idx; } else if (idx < 6) { kind = 1; head = idx - 4; } else { kind = 3; head = idx - 8; }
  }
  constexpr int RROW = 272;
  const bool needs_rope = (kind != 3) && (branch != 2);
  if (needs_rope) {
    const int s0 = m0 & 8191;
    const __amdgpu_buffer_rsrc_t rst = mk_rsrc(p.ws + OFF_T32);
    if (branch == 0) {
      for (int idx = tid; idx < 66 * 16; idx += 512) {
        const int row = idx >> 4, c = idx & 15;
        const int pos = row < 64 ? row : (s0 >> 6) + (row - 64);
        *(u32x4*)(lds + row * RROW + c * 16) = ld16(rst, (size_t)(pos * 16 + c) * 16);
      }
      if (tid < 64) ((float*)(lds + 66 * RROW))[tid] = (kind == 0 ? p.qn_a : p.kn_a)[l * 64 + tid];
    } else {
      for (int idx = tid; idx < 128 * 16; idx += 512) {
        const int row = idx >> 4, c = idx & 15;
        *(u32x4*)(lds + row * RROW + c * 16) = ld16(rst, (size_t)((s0 + row) * 16 + c) * 16);
      }
    }
    __syncthreads();
  }
  const float* gl = (const float*)(lds + 66 * RROW);
#pragma unroll
  for (int i = 0; i < 1; ++i) {
    const int token = m0 + 32 * wm + r;
    const int tl = 32 * wm + r;
    const int b = token >> 13, s = token & 8191;
    f32x16 v0 = acc[i][0], v1 = acc[i][1];
    if (kind == 3) {
      bf16_t* dst = (bf16_t*)(p.ws + OFF_GATE) + (size_t)token * 1024 + branch * 256 + head * 64 + 4 * h;
#pragma unroll
      for (int g = 0; g < 4; ++g) {
        float t[8];
#pragma unroll
        for (int e = 0; e < 4; ++e) {
          const float a0 = v0[4 * g + e], a1 = v1[4 * g + e];
          t[e] = a0 * __builtin_amdgcn_rcpf(1.f + __builtin_amdgcn_exp2f(-a0 * LOG2E));
          t[4 + e] = a1 * __builtin_amdgcn_rcpf(1.f + __builtin_amdgcn_exp2f(-a1 * LOG2E));
        }
        u32x2 o0, o1;
        o0[0] = pk2(t[0], t[1]); o0[1] = pk2(t[2], t[3]);
        o1[0] = pk2(t[4], t[5]); o1[1] = pk2(t[6], t[7]);
        *(u32x2*)(dst + 8 * g) = o0;
        *(u32x2*)(dst + 32 + 8 * g) = o1;
      }
      continue;
    }
    if (branch == 0) {
      float ss = 0.f;
#pragma unroll
      for (int e = 0; e < 16; ++e) ss += v0[e] * v0[e] + v1[e] * v1[e];
      ss += xor32(ss);
      const float rstd = rsqrtf(ss * (1.f / 64.f) + EPSV);
#pragma unroll
      for (int e = 0; e < 16; ++e) {
        v0[e] = v0[e] * rstd * gl[crow(e, h)];
        v1[e] = v1[e] * rstd * gl[32 + crow(e, h)];
      }
    }
    if (branch == 0 || branch == 3) {
      const int row0 = (branch == 0) ? (64 + (tl >> 6)) : tl;
      const int row1 = (branch == 0) ? (tl & 63) : tl;
#pragma unroll
      for (int e = 0; e < 8; ++e) {
        const int jf = crow(e, h);
        const float2 c0 = *(const float2*)(lds + row0 * RROW + jf * 16);
        const float2 c1 = *(const float2*)(lds + row1 * RROW + jf * 16);
        const float a1 = v0[e], a2 = v0[e + 8];
        v0[e] = a1 * c0.x - a2 * c0.y; v0[e + 8] = a2 * c0.x + a1 * c0.y;
        const float b1 = v1[e], b2 = v1[e + 8];
        v1[e] = b1 * c1.x - b2 * c1.y; v1[e + 8] = b2 * c1.x + b1 * c1.y;
      }
    } else if (branch == 1) {
#pragma unroll
      for (int e = 0; e < 16; ++e) {
        const int jf = crow(e, h);
        const float2 c = *(const float2*)(lds + tl * RROW + jf * 8);
        const float a1 = v0[e], a2 = v1[e];
        v0[e] = a1 * c.x - a2 * c.y; v1[e] = a2 * c.x + a1 * c.y;
      }
    }
    float sc = 1.f;
    if (kind == 0) sc = (branch == 3) ? (0.17677669529663687f * LOG2E) : (0.125f * LOG2E);
    bf16_t* dst;
    if (kind == 0) {
      const size_t qoff = (branch == 0) ? OFF_QA : (branch == 1) ? OFF_QB : (branch == 2) ? OFF_QC : OFF_QD;
      dst = (bf16_t*)(p.ws + qoff) + ((size_t)(b * 4 + head) * SEQ + s) * 64;
    } else {
      const size_t koff = (branch == 0) ? OFF_KA : (branch == 1) ? OFF_KB : (branch == 2) ? OFF_KC : OFF_KD;
      const int nh = (branch == 2) ? 4 : 2;
      dst = (bf16_t*)(p.ws + koff) + ((size_t)(b * nh + head) * SEQ + s) * 64;
    }
    dst += 4 * h;
#pragma unroll
    for (int g = 0; g < 4; ++g) {
      u32x2 o0, o1;
      o0[0] = pk2(v0[4 * g] * sc, v0[4 * g + 1] * sc); o0[1] = pk2(v0[4 * g + 2] * sc, v0[4 * g + 3] * sc);
      o1[0] = pk2(v1[4 * g] * sc, v1[4 * g + 1] * sc); o1[1] = pk2(v1[4 * g + 2] * sc, v1[4 * g + 3] * sc);
      *(u32x2*)(dst + 8 * g) = o0;
      *(u32x2*)(dst + 32 + 8 * g) = o1;
    }
  }
}

__device__ void outproj_tile(const Params& p, int l, int tile, char* lds, const float* __restrict__ xin, float* __restrict__ xout) {
  const int tid = opaque_tid(), w = tid >> 6, lane = tid & 63, r = lane & 31, h = lane >> 5;
  const int wm = w & 3, wn = w >> 2;
  const int nt = tile & 7, mt = tile >> 3;
  const int m0 = mt * 128, n0 = nt * 128;
  const bf16_t* Mx = (const bf16_t*)(p.ws + OFF_MIX);
  const bf16_t* Wt = (const bf16_t*)(p.ws + OFF_WOUT) + (size_t)l * 1024 * 1024;
  f32x16 acc[1][2];
  const __amdgpu_buffer_rsrc_t rsxin = mk_rsrc(xin);
  gemm_mainloop<false>(Mx, Wt, m0, n0, lds, acc);
#pragma unroll
  for (int i = 0; i < 1; ++i)
#pragma unroll
    for (int j = 0; j < 2; ++j) {
      const int n = n0 + 64 * wn + 32 * j + r;
#pragma unroll
      for (int e = 0; e < 16; ++e) {
        const int m = m0 + 32 * wm + crow(e, h);
        const size_t o = (size_t)m * DM + n;
        xout[o] = __uint_as_float(ld4(rsxin, o * 4)) + acc[i][j][e];
      }
    }
}

enum { MA = 0, MB = 1, MC = 2, MD = 3 };

template <int MODE>
__device__ void attn_item(const Params& p, int l, int item, char* lds) {
  const int tid = opaque_tid(), w = tid >> 6, lane = tid & 63, r = lane & 31, h = lane >> 5;
  const int qg = w & 3, role = w >> 2;
  constexpr int NKS = (MODE == MD) ? 2 : 4;
  constexpr bool FAST = (MODE == MA || MODE == MD);
  constexpr bool NEGM = FAST;
  constexpr float P_THR = 256.f;
  float* ldsR = (float*)(lds + 256 * LROW);

  int b, qtok, ktlo, kthi, head_out, koff = 0;
  const bf16_t *Qp, *Kg, *Vg;
  int qrow = 0, rs = 0, qcol0 = 0;
  if (MODE == MA || MODE == MB) {
    b = item >> 7; const int kvh = (item >> 6) & 1, qb = item & 63;
    qtok = qb * 128 + 32 * qg + r;
    head_out = kvh * 2 + role;
    Qp = (const bf16_t*)(p.ws + (MODE == MA ? OFF_QA : OFF_QB)) + ((size_t)(b * 4 + head_out) * SEQ + qtok) * 64 + 8 * h;
    const int kvrow = b * 2 + kvh;
    Kg = (const bf16_t*)(p.ws + (MODE == MA ? OFF_KA : OFF_KB)) + (size_t)kvrow * SEQ * 64;
    Vg = (const bf16_t*)(p.ws + (MODE == MA ? OFF_VA : OFF_VB)) + (size_t)kvrow * 64 * SEQ;
    if (MODE == MA) { ktlo = 0; kthi = 128; }
    else { ktlo = max(0, qb * 2 - 2); kthi = min(128, qb * 2 + 4); }
  } else if (MODE == MD) {
    b = item >> 8; const int hq = (item >> 6) & 3, qb = item & 63;
    qtok = qb * 128 + 32 * qg + r;
    head_out = hq;
    koff = 32 * role;
    Qp = (const bf16_t*)(p.ws + OFF_QD) + ((size_t)(b * 4 + hq) * SEQ + qtok) * 64 + koff + 8 * h;
    const int kvrow = b * 2 + (hq >> 1);
    Kg = (const bf16_t*)(p.ws + OFF_KD) + (size_t)kvrow * SEQ * 64;
    Vg = (const bf16_t*)(p.ws + OFF_VD) + (size_t)kvrow * 64 * SEQ;
    ktlo = 0; kthi = 128;
  } else {
    b = item >> 7; const int hh = (item >> 5) & 3, rg = item & 31;
    qrow = rg * 4 + qg;
    rs = min(max(qrow - 4, 0), 120);
    qcol0 = 32 * role;
    qtok = qrow * 64 + qcol0 + r;
    head_out = hh;
    Qp = (const bf16_t*)(p.ws + OFF_QC) + ((size_t)(b * 4 + hh) * SEQ + qtok) * 64 + 8 * h;
    const int kvrow = b * 4 + hh;
    Kg = (const bf16_t*)(p.ws + OFF_KC) + (size_t)kvrow * SEQ * 64;
    Vg = (const bf16_t*)(p.ws + OFF_VC) + (size_t)kvrow * 64 * SEQ;
    ktlo = min(max(rg * 4 - 4, 0), 120);
    kthi = min(max(rg * 4 + 3 - 4, 0), 120) + 8;
    const float* rp = p.rpb_c + ((size_t)l * 4 + hh) * 465;
    for (int i = tid; i < 465; i += 512) ldsR[i] = rp[i] * LOG2E;
  }

  const __amdgpu_buffer_rsrc_t rsw = mk_rsrc(p.ws);
  bf16x8 qf[NKS];
#pragma unroll
  for (int ks = 0; ks < NKS; ++ks) qf[ks] = __builtin_bit_cast(bf16x8, ld16(rsw, (size_t)((const char*)(Qp + 16 * ks) - p.ws)));

  f32x16 O[2];
#pragma unroll
  for (int db = 0; db < 2; ++db)
#pragma unroll
    for (int e = 0; e < 16; ++e) O[db][e] = 0.f;
  float mrun, lrun;
  if (MODE == MB) { mrun = p.sink_b[l * 4 + head_out] * LOG2E; lrun = 0.5f; }
  else { mrun = NEG; lrun = 0.f; }
  f32x16 negm;
  if (FAST) {
    f32x16 s0;
#pragma unroll
    for (int e = 0; e < 16; ++e) s0[e] = 0.f;
#pragma unroll
    for (int ks = 0; ks < NKS; ++ks) {
      const bf16_t* kp = Kg + ((size_t)ktlo * 64 + r) * 64 + koff + 16 * ks + 8 * h;
      const bf16x8 k0 = __builtin_bit_cast(bf16x8, ld16(rsw, (size_t)((const char*)kp - p.ws)));
      s0 = MFMA(k0, qf[ks], s0);
    }
    float m0 = s0[0];
#pragma unroll
    for (int e = 1; e < 16; ++e) m0 = fmaxf(m0, s0[e]);
    m0 = fmaxf(m0, xor32(m0));
    mrun = m0;
#pragma unroll
    for (int e = 0; e < 16; ++e) negm[e] = -m0;
  }
  u32x4 kreg, vreg;
  const int lrow = tid >> 3, lch = tid & 7;
  const bf16_t* kgp = Kg + (size_t)lrow * 64 + lch * 8;
  const bf16_t* vgp = Vg + (size_t)lrow * SEQ + lch * 8;
  kreg = ld16(rsw, (size_t)((const char*)(kgp + (size_t)ktlo * 64 * 64) - p.ws));
  vreg = ld16(rsw, (size_t)((const char*)(vgp + ktlo * 64) - p.ws));
  const int soff = lrow * LROW + lch * 16;
  const int vsoff = lrow * LROW + (lch >> 1) * 32 + (lch & 1) * 8;

  __syncthreads();
  *(u32x4*)(lds + soff) = kreg;
  { u32x2 lo_ = {vreg[0], vreg[1]}, hi_ = {vreg[2], vreg[3]}; *(u32x2*)(lds + 64 * LROW + vsoff) = lo_; *(u32x2*)(lds + 64 * LROW + vsoff + 16) = hi_; }
  if (ktlo + 1 < kthi) {
    kreg = ld16(rsw, (size_t)((const char*)(kgp + (size_t)(ktlo + 1) * 64 * 64) - p.ws));
    vreg = ld16(rsw, (size_t)((const char*)(vgp + (ktlo + 1) * 64) - p.ws));
  }
  __syncthreads();
  for (int kt = ktlo; kt < kthi; ++kt) {
    const int cur = (kt - ktlo) & 1;
    const char* ldsK = lds + cur * 128 * LROW;
    const char* ldsV = ldsK + 64 * LROW;
    if (kt + 1 < kthi) {
      char* nb = lds + (cur ^ 1) * 128 * LROW;
      *(u32x4*)(nb + soff) = kreg;
      { u32x2 lo_ = {vreg[0], vreg[1]}, hi_ = {vreg[2], vreg[3]}; *(u32x2*)(nb + 64 * LROW + vsoff) = lo_; *(u32x2*)(nb + 64 * LROW + vsoff + 16) = hi_; }
    }
    if (kt + 2 < kthi) {
      kreg = ld16(rsw, (size_t)((const char*)(kgp + (size_t)(kt + 2) * 64 * 64) - p.ws));
      vreg = ld16(rsw, (size_t)((const char*)(vgp + (kt + 2) * 64) - p.ws));
    }
    bool active = true;
    if (MODE == MC) active = (kt >= rs) && (kt < rs + 8);
    if (active) {
#pragma nounroll
      for (int kb = 0; kb < 2; ++kb) {
        bf16x8 pf[2];
        if (FAST) {
          f32x16 S = negm;
#pragma unroll
          for (int ks = 0; ks < NKS; ++ks) {
            const bf16x8 k0 = *(const bf16x8*)(ldsK + (32 * kb + r) * LROW + (koff + 16 * ks + 8 * h) * 2);
            S = MFMA(k0, qf[ks], S);
          }
          float ls = 0.f;
#pragma unroll
          for (int e = 0; e < 16; ++e) { S[e] = __builtin_amdgcn_exp2f(S[e]); ls += S[e]; }
          if (__any(!(ls <= P_THR))) {
            S = negm;
#pragma unroll
            for (int ks = 0; ks < NKS; ++ks) {
              const bf16x8 k0 = *(const bf16x8*)(ldsK + (32 * kb + r) * LROW + (koff + 16 * ks + 8 * h) * 2);
              S = MFMA(k0, qf[ks], S);
            }
            float mx = S[0];
#pragma unroll
            for (int e = 1; e < 16; ++e) mx = fmaxf(mx, S[e]);
            mx = fmaxf(mx, xor32(mx));
            const float d = fmaxf(mx, 0.f);
            const float alpha = __builtin_amdgcn_exp2f(-d);
            mrun += d;
            lrun *= alpha;
#pragma unroll
            for (int db = 0; db < 2; ++db)
#pragma unroll
              for (int e = 0; e < 16; ++e) O[db][e] *= alpha;
#pragma unroll
            for (int e = 0; e < 16; ++e) negm[e] -= d;
            ls = 0.f;
#pragma unroll
            for (int e = 0; e < 16; ++e) { S[e] = __builtin_amdgcn_exp2f(S[e] - d); ls += S[e]; }
          }
#pragma unroll
          for (int s = 0; s < 2; ++s) {
            u32x4 pk;
            pk[0] = pk2(S[8 * s + 0], S[8 * s + 1]); pk[1] = pk2(S[8 * s + 2], S[8 * s + 3]);
            pk[2] = pk2(S[8 * s + 4], S[8 * s + 5]); pk[3] = pk2(S[8 * s + 6], S[8 * s + 7]);
            pf[s] = __builtin_bit_cast(bf16x8, pk);
          }
          lrun += ls;
        } else {
          f32x16 S;
#pragma unroll
          for (int e = 0; e < 16; ++e) S[e] = 0.f;
#pragma unroll
          for (int ks = 0; ks < NKS; ++ks) {
            const bf16x8 k0 = *(const bf16x8*)(ldsK + (32 * kb + r) * LROW + (16 * ks + 8 * h) * 2);
            S = MFMA(k0, qf[ks], S);
          }
          if (MODE == MB) {
#pragma unroll
            for (int e = 0; e < 16; ++e) {
              const int kpos = kt * 64 + 32 * kb + crow(e, h);
              const int dlt = qtok - kpos;
              const bool ok = (dlt <= 128) && (dlt >= -128);
              S[e] = ok ? S[e] : NEG;
            }
          }
          if (MODE == MC) {
            const int dr = kt - qrow + 7;
            const int qcol = qcol0 + r;
            const int cs = min(max(qcol - 8, 0), 48);
#pragma unroll
            for (int e = 0; e < 16; ++e) {
              const int kcol = 32 * kb + crow(e, h);
              const bool ok = (kcol >= cs) && (kcol < cs + 16);
              const int dc = min(max(kcol - qcol, -15), 15) + 15;
              const float bias = ldsR[dr * 31 + dc];
              S[e] = ok ? (S[e] + bias) : NEG;
            }
          }
          float mx = S[0];
#pragma unroll
          for (int e = 1; e < 16; ++e) mx = fmaxf(mx, S[e]);
          mx = fmaxf(mx, xor32(mx));
          if (__any(mx > mrun)) {
            const float mn = fmaxf(mrun, mx);
            const float alpha = __builtin_amdgcn_exp2f(mrun - mn);
            mrun = mn;
            lrun *= alpha;
#pragma unroll
            for (int db = 0; db < 2; ++db)
#pragma unroll
              for (int e = 0; e < 16; ++e) O[db][e] *= alpha;
          }
          const float mn = mrun;
          float ls = 0.f;
#pragma unroll
          for (int e = 0; e < 16; ++e) {
            const float pvv = __builtin_amdgcn_exp2f(S[e] - mn);
            S[e] = pvv;
            ls += pvv;
          }
          lrun += ls;
#pragma unroll
          for (int s = 0; s < 2; ++s) {
            u32x4 pk;
            pk[0] = pk2(S[8 * s + 0], S[8 * s + 1]); pk[1] = pk2(S[8 * s + 2], S[8 * s + 3]);
            pk[2] = pk2(S[8 * s + 4], S[8 * s + 5]); pk[3] = pk2(S[8 * s + 6], S[8 * s + 7]);
            pf[s] = __builtin_bit_cast(bf16x8, pk);
          }
        }
#pragma unroll
        for (int s = 0; s < 2; ++s)
#pragma unroll
          for (int db = 0; db < 2; ++db) {
            const bf16x8 vf = *(const bf16x8*)(ldsV + (32 * db + r) * LROW + (32 * kb + 16 * s) * 2 + 16 * h);
            O[db] = MFMA(vf, pf[s], O[db]);
          }
      }
    }
    __syncthreads();
  }

  bf16_t* mix = (bf16_t*)(p.ws + OFF_MIX);
  lrun += xor32(lrun);
  const float inv = 1.f / lrun;
  if (MODE == MD) {
    float* xch = (float*)lds + (size_t)qg * 32 * 64 + lane;
    __syncthreads();
    if (role == 1) {
#pragma unroll
      for (int db = 0; db < 2; ++db)
#pragma unroll
        for (int e = 0; e < 16; ++e) xch[(db * 16 + e) * 64] = O[db][e] * inv;
    }
    __syncthreads();
    if (role == 1) return;
    const float lam = __uint_as_float(ld4(rsw, OFF_CTRL + (16 + l * 2 + 0) * 4)), omli = __uint_as_float(ld4(rsw, OFF_CTRL + (16 + l * 2 + 1) * 4));
    f32x16 o[2];
    float ss = 0.f;
#pragma unroll
    for (int db = 0; db < 2; ++db)
#pragma unroll
      for (int e = 0; e < 16; ++e) {
        const float t = O[db][e] * inv - lam * xch[(db * 16 + e) * 64];
        o[db][e] = t;
        ss += t * t;
      }
    ss += xor32(ss);
    const float rstd = rsqrtf(ss * (1.f / 64.f) + EPSV) * omli;
    const size_t base = (size_t)(b * SEQ + qtok) * 1024 + 768 + head_out * 64 + 4 * h;
    const float* sg = p.subln + l * 64 + 4 * h;
#pragma unroll
    for (int db = 0; db < 2; ++db)
#pragma unroll
      for (int g = 0; g < 4; ++g) {
        const size_t off = base + 32 * db + 8 * g;
        const u32x2 gv = ld8(rsw, OFF_GATE + off * 2);
        const float g0 = __uint_as_float(gv[0] << 16), g1 = __uint_as_float(gv[0] & 0xffff0000u);
        const float g2 = __uint_as_float(gv[1] << 16), g3 = __uint_as_float(gv[1] & 0xffff0000u);
        const float* sgp = sg + 32 * db + 8 * g;
        u32x2 ov;
        ov[0] = pk2(o[db][4 * g + 0] * rstd * sgp[0] * g0, o[db][4 * g + 1] * rstd * sgp[1] * g1);
        ov[1] = pk2(o[db][4 * g + 2] * rstd * sgp[2] * g2, o[db][4 * g + 3] * rstd * sgp[3] * g3);
        *(u32x2*)(mix + off) = ov;
      }
  } else {
    const int brc = (MODE == MA) ? 0 : (MODE == MB) ? 256 : 512;
    const size_t base = (size_t)(b * SEQ + qtok) * 1024 + brc + head_out * 64 + 4 * h;
#pragma unroll
    for (int db = 0; db < 2; ++db)
#pragma unroll
      for (int g = 0; g < 4; ++g) {
        const size_t off = base + 32 * db + 8 * g;
        const u32x2 gv = ld8(rsw, OFF_GATE + off * 2);
        const float g0 = __uint_as_float(gv[0] << 16), g1 = __uint_as_float(gv[0] & 0xffff0000u);
        const float g2 = __uint_as_float(gv[1] << 16), g3 = __uint_as_float(gv[1] & 0xffff0000u);
        u32x2 ov;
        ov[0] = pk2(O[db][4 * g + 0] * inv * g0, O[db][4 * g + 1] * inv * g1);
        ov[1] = pk2(O[db][4 * g + 2] * inv * g2, O[db][4 * g + 3] * inv * g3);
        *(u32x2*)(mix + off) = ov;
      }
  }
}

constexpr int N_D = 512, N_A = 256, N_B = 256, N_C = 256;
constexpr int N_ATT = N_D + N_A + N_B + N_C;

__device__ void phase_prep(const Params& p, char* lds) {
  const int tid = opaque_tid();
  const int gtid = blockIdx.x * blockDim.x + tid, nth = gridDim.x * blockDim.x;
  if (blockIdx.x == 0 && tid == 0) {
    float* cf = (float*)(p.ws + OFF_CTRL) + 16;
    for (int l = 0; l < 2; ++l) {
      float s1 = 0.f, s2 = 0.f;
      for (int i = 0; i < 32; ++i) { s1 += p.lq1[l * 32 + i] * p.lk1[l * 32 + i]; s2 += p.lq2[l * 32 + i] * p.lk2[l * 32 + i]; }
      const float li = (l == 0) ? 0.2f : 0.35550906759096934f;
      cf[l * 2 + 0] = __expf(s1) - __expf(s2) + li;
      cf[l * 2 + 1] = 1.0f - li;
    }
  }
  float2* T32 = (float2*)(p.ws + OFF_T32);
  for (int i = gtid; i < SEQ * 32; i += nth) {
    const int pos = i >> 5, j = i & 31;
    const float ang = (float)pos * INV32[j];
    float sn, cs;
    sincos_d(ang, sn, cs);
    T32[i] = make_float2(cs, sn);
  }
  const int half = tid >> 8, tl = tid & 255;
  for (int tp = blockIdx.x; tp < 832 + 256; tp += gridDim.x) {
    const int t = 2 * tp + half;
    const int l = t / 1088, tt = t % 1088;
    float* lf = (float*)(lds + half * 20480);
    if (tt < 832) wconv_tile(p.w_in + (size_t)l * 1024 * DIN, p.norm_g + l * 1024, (bf16_t*)(p.ws + OFF_WIN) + (size_t)l * DIN * 1024, DIN, tt, lf, tl);
    else wconv_tile(p.w_out + (size_t)l * 1024 * 1024, nullptr, (bf16_t*)(p.ws + OFF_WOUT) + (size_t)l * 1024 * 1024, 1024, tt - 832, lf, tl);
  }
  rms_rows<false>(p.x, (bf16_t*)(p.ws + OFF_H), nullptr, nullptr);
}

__device__ void phase_inproj(const Params& p, int l, char* lds) {
  if ((gridDim.x & 7) == 0) {
    const int xcd = blockIdx.x & 7, slot = blockIdx.x >> 3, slots = gridDim.x >> 3;
    for (int q = slot; q < 16 * 26; q += slots) {
      int mtl, nt;
      if (q < 384) { const int ng = q >> 7, rem = q & 127, w8 = rem & 63; mtl = (rem >> 6) * 8 + (w8 & 7); nt = ng * 8 + (w8 >> 3); }
      else { const int rem = q - 384; mtl = rem & 15; nt = 24 + (rem >> 4); }
      inproj_tile(p, l, (xcd * 16 + mtl) * 26 + nt, lds);
    }
  } else {
    for (int t = blockIdx.x; t < 128 * 26; t += gridDim.x) inproj_tile(p, l, t, lds);
  }
}

DI int fetch_item(unsigned* ctr, int* s_item) {
  __syncthreads();
  if (threadIdx.x == 0) *s_item = (int)atomicAdd(ctr, 1u);
  __syncthreads();
  return *s_item;
}

__device__ void phase_attn(const Params& p, int l, char* lds, int* s_item, int cidx) {
  unsigned* ctr = (unsigned*)(p.ws + OFF_CTRL) + cidx;
  int item = blockIdx.x;
  while (item < N_A) { attn_item<MA>(p, l, item, lds); item = (int)gridDim.x + fetch_item(ctr, s_item); }
  while (item < N_A + N_D) { attn_item<MD>(p, l, item - N_A, lds); item = (int)gridDim.x + fetch_item(ctr, s_item); }
  while (item < N_A + N_D + N_B) { attn_item<MB>(p, l, item - N_A - N_D, lds); item = (int)gridDim.x + fetch_item(ctr, s_item); }
  while (item < N_ATT) { attn_item<MC>(p, l, item - N_A - N_D - N_B, lds); item = (int)gridDim.x + fetch_item(ctr, s_item); }
}

__device__ void phase_outproj(const Params& p, int l, char* lds) {
  const float* xin = (l == 0) ? p.x : (const float*)(p.ws + OFF_X1);
  float* xout = (l == 0) ? (float*)(p.ws + OFF_X1) : p.out;
  if ((gridDim.x & 7) == 0) {
    const int xcd = blockIdx.x & 7, slot = blockIdx.x >> 3, slots = gridDim.x >> 3;
    for (int q = slot; q < 16 * 8; q += slots) {
      const int w8 = q & 63, mtl = (q >> 6) * 8 + (w8 & 7), nt = w8 >> 3;
      outproj_tile(p, l, (xcd * 16 + mtl) * 8 + nt, lds, xin, xout);
    }
  } else {
    for (int t = blockIdx.x; t < 128 * 8; t += gridDim.x) outproj_tile(p, l, t, lds, xin, xout);
  }
}

__global__ void __launch_bounds__(512, 4) fwd_megakernel(Params p) {
  __shared__ __attribute__((aligned(16))) char lds[4 * 128 * LROW];
  __shared__ int s_item;
  __shared__ uint4 xb_words;
  if (p.ws == nullptr) cg::this_grid().sync();
  if (threadIdx.x == 0) xb_words = make_uint4(0u, 0u, 0u, 0u);
  __syncthreads();
  XcdBarrier gb = xcd_barrier_post((unsigned*)(p.ws + OFF_BAR), (volatile LAS unsigned*)&xb_words);
  phase_prep(p, lds);
  xcd_barrier(gb);
  for (int l = 0; l < 2; ++l) {
    phase_inproj(p, l, lds);
    xcd_barrier(gb);
    phase_attn(p, l, lds, &s_item, l);
    xcd_barrier(gb);
#ifdef PROBE_ATTN2
    phase_attn(p, l, lds, &s_item, l + 2);
    xcd_barrier(gb);
#endif
#ifdef PROBE_GEMM2
    phase_inproj(p, l, lds);
    xcd_barrier(gb);
#endif
    phase_outproj(p, l, lds);
    xcd_barrier(gb);
    if (l == 0) {
      rms_rows<false>((const float*)(p.ws + OFF_X1), (bf16_t*)(p.ws + OFF_H), nullptr, nullptr);
      xcd_barrier(gb);
    } else {
      rms_rows<true>(p.out, nullptr, p.out, p.final_g);
    }
  }
}

extern "C" void kernel_launch(void* const* d_in, const int* in_sizes, int n_in, void* d_out,
                              int out_size, void* d_ws, size_t ws_size, hipStream_t stream) {
  static int grid_blocks = 0;
  if (!grid_blocks) {
    int dev = 0, cus = 0, per_cu = 0;
    (void)hipGetDevice(&dev);
    (void)hipDeviceGetAttribute(&cus, hipDeviceAttributeMultiprocessorCount, dev);
    (void)hipOccupancyMaxActiveBlocksPerMultiprocessor(&per_cu, fwd_megakernel, 512, 0);
    if (per_cu > 2) per_cu = 2;
    if (per_cu < 1) per_cu = 1;
    grid_blocks = cus * per_cu;
  }
  if (ws_size < WS_NEEDED) { fprintf(stderr, "workspace too small\n"); return; }
  Params p{};
  p.x = (const float*)d_in[0]; p.norm_g = (const float*)d_in[1]; p.w_in = (const float*)d_in[2]; p.w_out = (const float*)d_in[3];
  p.qn_a = (const float*)d_in[4]; p.kn_a = (const float*)d_in[5]; p.sink_b = (const float*)d_in[6]; p.rpb_c = (const float*)d_in[7];
  p.lq1 = (const float*)d_in[8]; p.lk1 = (const float*)d_in[9]; p.lq2 = (const float*)d_in[10]; p.lk2 = (const float*)d_in[11];
  p.subln = (const float*)d_in[12]; p.final_g = (const float*)d_in[13];
  p.out = (float*)d_out; p.ws = (char*)d_ws;
  (void)hipMemsetAsync(d_ws, 0, OFF_T32, stream);
  void* args[] = {&p};
  hipError_t e = hipLaunchCooperativeKernel((void*)fwd_megakernel, dim3(grid_blocks), dim3(512), args, 0, stream);
  if (e != hipSuccess) fprintf(stderr, "cooperative launch failed: %s (grid %d)\n", hipGetErrorString(e), grid_blocks);
}
```

```cpp
#include <hip/hip_runtime.h>
#include <hip/hip_cooperative_groups.h>
#include <cstdio>
#include <cstdint>
namespace cg = cooperative_groups;

#define DI __device__ __forceinline__
typedef unsigned short bf16_t;
typedef short bf16x8 __attribute__((ext_vector_type(8)));
typedef short s16x4 __attribute__((ext_vector_type(4)));
typedef float f32x16 __attribute__((ext_vector_type(16)));
typedef float f32x4 __attribute__((ext_vector_type(4)));
typedef float f32x2 __attribute__((ext_vector_type(2)));
typedef __bf16 bf16x2_t __attribute__((ext_vector_type(2)));
typedef unsigned u32x2 __attribute__((ext_vector_type(2)));
typedef unsigned u32x4 __attribute__((ext_vector_type(4)));

#define MFMA(a, b, c) __builtin_amdgcn_mfma_f32_32x32x16_bf16((a), (b), (c), 0, 0, 0)

constexpr int SEQ = 8192, DM = 1024, DIN = 3328, MTOK = 16384;
constexpr float LOG2E = 1.4426950408889634f;
constexpr float EPSV = 1e-6f;
constexpr float NEG = -1e30f;

constexpr size_t MiB = 1024 * 1024;
constexpr size_t OFF_BAR = 0;
constexpr size_t OFF_CTRL = 16384;
constexpr size_t OFF_T32 = 20480;
constexpr size_t OFF_WIN = OFF_T32 + 2 * MiB;
constexpr size_t OFF_WOUT = OFF_WIN + 13 * MiB;
constexpr size_t OFF_H = OFF_WOUT + 4 * MiB;
constexpr size_t OFF_QA = OFF_H + 32 * MiB;
constexpr size_t OFF_KA = OFF_QA + 8 * MiB;
constexpr size_t OFF_VA = OFF_KA + 4 * MiB;
constexpr size_t OFF_QB = OFF_VA + 4 * MiB;
constexpr size_t OFF_KB = OFF_QB + 8 * MiB;
constexpr size_t OFF_VB = OFF_KB + 4 * MiB;
constexpr size_t OFF_QC = OFF_VB + 4 * MiB;
constexpr size_t OFF_KC = OFF_QC + 8 * MiB;
constexpr size_t OFF_VC = OFF_KC + 8 * MiB;
constexpr size_t OFF_QD = OFF_VC + 8 * MiB;
constexpr size_t OFF_KD = OFF_QD + 8 * MiB;
constexpr size_t OFF_VD = OFF_KD + 4 * MiB;
constexpr size_t OFF_GATE = OFF_VD + 4 * MiB;
constexpr size_t OFF_X1 = OFF_GATE + 32 * MiB;
constexpr size_t OFF_MIX = OFF_X1 + 64 * MiB;
constexpr size_t WS_NEEDED = OFF_MIX + 32 * MiB;

struct Params {
  const float *x, *norm_g, *w_in, *w_out, *qn_a, *kn_a, *sink_b, *rpb_c, *lq1, *lk1, *lq2, *lk2, *subln, *final_g;
  float* out;
  char* ws;
};

__device__ const float INV32[32] = {
    1.000000000e+00f, 7.498942614e-01f, 5.623413324e-01f, 4.216965139e-01f, 3.162277639e-01f, 2.371373773e-01f,
    1.778279394e-01f, 1.333521307e-01f, 1.000000015e-01f, 7.498941571e-02f, 5.623413250e-02f, 4.216965288e-02f,
    3.162277490e-02f, 2.371373773e-02f, 1.778279431e-02f, 1.333521493e-02f, 9.999999776e-03f, 7.498941850e-03f,
    5.623413250e-03f, 4.216964822e-03f, 3.162277630e-03f, 2.371373586e-03f, 1.778279431e-03f, 1.333521446e-03f,
    1.000000047e-03f, 7.498942432e-04f, 5.623413017e-04f, 4.216965172e-04f, 3.162277571e-04f, 2.371373703e-04f,
    1.778279402e-04f, 1.333521504e-04f};

DI unsigned pk2(float a, float b) {
  f32x2 v = {a, b};
  return __builtin_bit_cast(unsigned, __builtin_convertvector(v, bf16x2_t));
}
DI float bf2f(unsigned short u) { return __uint_as_float(((unsigned)u) << 16); }
DI int crow(int reg, int h) { return (reg & 3) + 8 * (reg >> 2) + 4 * h; }
DI float xor32(float v) { return __shfl_xor(v, 32); }
DI __amdgpu_buffer_rsrc_t mk_rsrc(const void* base) { return __builtin_amdgcn_make_buffer_rsrc((void*)base, 0, 0x7fffffff, 0x00020000); }
DI u32x4 ld16(__amdgpu_buffer_rsrc_t rs, size_t byte_off) { return __builtin_amdgcn_raw_buffer_load_b128(rs, (int)(unsigned)byte_off, 0, 16); }
DI u32x2 ld8(__amdgpu_buffer_rsrc_t rs, size_t byte_off) { return __builtin_amdgcn_raw_buffer_load_b64(rs, (int)(unsigned)byte_off, 0, 16); }
DI unsigned ld4(__amdgpu_buffer_rsrc_t rs, size_t byte_off) { return __builtin_amdgcn_raw_buffer_load_b32(rs, (int)(unsigned)byte_off, 0, 16); }
DI int opaque_tid() { int t = threadIdx.x; asm volatile("" : "+v"(t)); return t; }


#define XB_TMO      128
#define XB_XCNT(j)  (256  + 64 * (j))
#define XB_XSUB(j)  (1280 + 64 * (j))
#define XB_XGEN(j)  (2304 + 64 * (j))
#define XB_TOP      3328
#define XB_TOPGEN   3392
#define XCD_BAR_WORDS 3456
#define XB_SPIN_CAP (1u << 20)
#define LAS __attribute__((address_space(3)))
DI unsigned xb_ld(unsigned* p) { return __hip_atomic_load(p, __ATOMIC_RELAXED, __HIP_MEMORY_SCOPE_AGENT); }
DI unsigned xb_add(unsigned* p, unsigned v) { return __hip_atomic_fetch_add(p, v, __ATOMIC_RELAXED, __HIP_MEMORY_SCOPE_AGENT); }
DI unsigned xb_xcc_id() { return (unsigned)__builtin_amdgcn_s_getreg((3 << 11) | 20) & 0xFu; }
#define XB_SPIN(cond, bar) do { unsigned _sp = 0; while (cond) { __builtin_amdgcn_s_sleep(1); \
    if ((++_sp & 255u) == 0u) { if (xb_ld(&(bar)[XB_TMO])) break; if (_sp > XB_SPIN_CAP) { atomicAdd(&(bar)[XB_TMO], 1u); break; } } } } while (0)
struct XcdBarrier { unsigned* bar; unsigned x; volatile LAS unsigned* st; };
DI XcdBarrier xcd_barrier_post(unsigned* bar, volatile LAS unsigned* st) {
  XcdBarrier b; b.bar = bar; b.x = xb_xcc_id(); b.st = st;
  if (threadIdx.x == 0) (void)xb_add(&bar[XB_XCNT(b.x)], 1u);
  return b;
}
DI void xcd_barrier_complete(unsigned* bar, unsigned x, unsigned& nloc, unsigned& nx) {
  const unsigned G = gridDim.x * gridDim.y * gridDim.z;
  unsigned sum, cnt, mine, sp = 0u;
  for (;;) {
    sum = 0u; cnt = 0u; mine = 0u;
#pragma unroll
    for (unsigned j = 0; j < 16; ++j) { const unsigned c = xb_ld(&bar[XB_XCNT(j)]); sum += c; cnt += (c > 0u) ? 1u : 0u; mine = (j == x) ? c : mine; }
    if (sum == G) break;
    __builtin_amdgcn_s_sleep(1);
    if ((++sp & 255u) == 0u) { if (xb_ld(&bar[XB_TMO])) break; if (sp > XB_SPIN_CAP) { atomicAdd(&bar[XB_TMO], 1u); break; } }
  }
  nloc = mine > 0u ? mine : 1u; nx = cnt > 0u ? cnt : 1u;
}
DI void xcd_barrier(const XcdBarrier& b) {
  asm volatile("s_waitcnt vmcnt(0)" ::: "memory");
  __syncthreads();
  if (threadIdx.x == 0) {
    unsigned* bar = b.bar;
    asm volatile("" : "+s"(bar));
    __builtin_amdgcn_s_waitcnt(0);
    unsigned nloc = b.st[0], nx = b.st[1];
    if (nloc == 0u) { xcd_barrier_complete(bar, b.x, nloc, nx); b.st[0] = nloc; b.st[1] = nx; }
    unsigned bx = b.x;
    asm volatile("" : "+s"(bx));
    const unsigned old = xb_add(&bar[XB_XSUB(bx)], 1u);
    const unsigned gen = old / nloc;
    if (old + 1u == (gen + 1u) * nloc) {
      __builtin_amdgcn_fence(__ATOMIC_RELEASE, "agent");
      asm volatile("s_waitcnt vmcnt(0)" ::: "memory");
      const unsigned og = xb_add(&bar[XB_TOP], 1u);
      const unsigned tg = og / nx;
      if (og + 1u == (tg + 1u) * nx) xb_add(&bar[XB_TOPGEN], 1u);
      else XB_SPIN(xb_ld(&bar[XB_TOPGEN]) == tg, bar);
      __builtin_amdgcn_fence(__ATOMIC_ACQUIRE, "agent");
      xb_add(&bar[XB_XGEN(bx)], 1u);
      asm volatile("s_waitcnt vmcnt(0)" ::: "memory");
    } else {
      XB_SPIN(xb_ld(&bar[XB_XGEN(bx)]) == gen, bar);
      __builtin_amdgcn_fence(__ATOMIC_ACQUIRE, "agent");
      asm volatile("s_waitcnt vmcnt(0)" ::: "memory");
    }
  }
  __syncthreads();
}

DI void sincos_d(float angf, float& sn, float& cs) {
  const double a = (double)angf;
  const double q = __builtin_rint(a * 0.63661977236758134308);
  double r = __builtin_fma(-q, 1.57079632679489655800e+00, a);
  r = __builtin_fma(-q, 6.12323399573676603587e-17, r);
  const int n = ((int)q) & 3;
  const double r2 = r * r;
  double sp = 1.0 / 6227020800.0;
  sp = sp * r2 - 1.0 / 39916800.0;
  sp = sp * r2 + 1.0 / 362880.0;
  sp = sp * r2 - 1.0 / 5040.0;
  sp = sp * r2 + 1.0 / 120.0;
  sp = sp * r2 - 1.0 / 6.0;
  sp = r + r * r2 * sp;
  double cp = -1.0 / 87178291200.0;
  cp = cp * r2 + 1.0 / 479001600.0;
  cp = cp * r2 - 1.0 / 3628800.0;
  cp = cp * r2 + 1.0 / 40320.0;
  cp = cp * r2 - 1.0 / 720.0;
  cp = cp * r2 + 1.0 / 24.0;
  cp = cp * r2 - 0.5;
  cp = 1.0 + r2 * cp;
  double s_, c_;
  if (n == 0) { s_ = sp; c_ = cp; }
  else if (n == 1) { s_ = cp; c_ = -sp; }
  else if (n == 2) { s_ = -sp; c_ = -cp; }
  else { s_ = -cp; c_ = sp; }
  sn = (float)s_; cs = (float)c_;
}

__device__ void wconv_tile(const float* __restrict__ W, const float* __restrict__ g, bf16_t* __restrict__ Wt, int N, int tile, float* lds, const int tid) {
  const int ntn = N >> 6;
  const int k0 = (tile / ntn) << 6, n0 = (tile % ntn) << 6;
  __syncthreads();
#pragma unroll
  for (int i = 0; i < 16; ++i) {
    const int k = i * 4 + (tid >> 6), n = tid & 63;
    float v = W[(size_t)(k0 + k) * N + n0 + n];
    if (g) v *= g[k0 + k];
    lds[k * 65 + n] = v;
  }
  __syncthreads();
#pragma unroll
  for (int i = 0; i < 16; ++i) {
    const int n = i * 4 + (tid >> 6), k = tid & 63;
    Wt[(size_t)(n0 + n) * 1024 + k0 + k] = (bf16_t)(pk2(lds[k * 65 + n], 0.f) & 0xffffu);
  }
}

template <bool FINAL>
__device__ void rms_rows(const float* X, bf16_t* H, float* O, const float* g) {
  const int t_ = opaque_tid();
  const int lane = t_ & 63;
  const int gw = (blockIdx.x * blockDim.x + t_) >> 6, nw = (gridDim.x * blockDim.x) >> 6;
  const __amdgpu_buffer_rsrc_t rsx = mk_rsrc(X);
  const __amdgpu_buffer_rsrc_t rso = mk_rsrc(FINAL ? (const void*)O : (const void*)X);
  for (int row = gw; row < MTOK; row += nw) {
    f32x4 v[4];
    float ss = 0.f;
#pragma unroll
    for (int i = 0; i < 4; ++i) {
      v[i] = __builtin_bit_cast(f32x4, ld16(rsx, ((size_t)row * DM + i * 256 + lane * 4) * 4));
      ss += v[i][0] * v[i][0] + v[i][1] * v[i][1] + v[i][2] * v[i][2] + v[i][3] * v[i][3];
    }
#pragma unroll
    for (int o = 32; o >= 1; o >>= 1) ss += __shfl_xor(ss, o);
    const float rstd = rsqrtf(ss * (1.0f / DM) + EPSV);
#pragma unroll
    for (int i = 0; i < 4; ++i) {
      if (FINAL) {
        const f32x4 gg = *(const f32x4*)(g + i * 256 + lane * 4);
        f32x4 o = v[i] * rstd * gg;
        __builtin_amdgcn_raw_buffer_store_b128(__builtin_bit_cast(u32x4, o), rso, (int)(unsigned)(((size_t)row * DM + i * 256 + lane * 4) * 4), 0, 16);
      } else {
        u32x2 o;
        o[0] = pk2(v[i][0] * rstd, v[i][1] * rstd);
        o[1] = pk2(v[i][2] * rstd, v[i][3] * rstd);
        *(u32x2*)(H + (size_t)row * DM + i * 256 + lane * 4) = o;
      }
    }
  }
}

constexpr int LROW = 144;
template <bool SWAP>
DI void gemm_mainloop(const bf16_t* __restrict__ A, const bf16_t* __restrict__ Bm, int m0, int n0, char* lds, f32x16 (&acc)[1][2]) {
  const int tid = opaque_tid(), w = tid >> 6, lane = tid & 63, r = lane & 31, h = lane >> 5;
  const int wm = w & 3, wn = w >> 2;
#pragma unroll
  for (int j = 0; j < 2; ++j)
#pragma unroll
    for (int e = 0; e < 16; ++e) acc[0][j][e] = 0.f;
  u32x4 ra[2], rb[2];
  const __amdgpu_buffer_rsrc_t rsa = mk_rsrc(A), rsb = mk_rsrc(Bm);
  const unsigned oa = (unsigned)(((size_t)(m0 + (tid >> 3)) * 1024 + (tid & 7) * 8) * 2);
  const unsigned ob = (unsigned)(((size_t)(n0 + (tid >> 3)) * 1024 + (tid & 7) * 8) * 2);
#pragma unroll
  for (int i = 0; i < 2; ++i) {
    ra[i] = ld16(rsa, oa + i * 64 * 2048);
    rb[i] = ld16(rsb, ob + i * 64 * 2048);
  }
  const int soff = (tid >> 3) * LROW + (tid & 7) * 16;
  __syncthreads();
#pragma unroll
  for (int i = 0; i < 2; ++i) {
    *(u32x4*)(lds + soff + i * 64 * LROW) = ra[i];
    *(u32x4*)(lds + 128 * LROW + soff + i * 64 * LROW) = rb[i];
  }
#pragma unroll
  for (int i = 0; i < 2; ++i) {
    ra[i] = ld16(rsa, oa + i * 64 * 2048 + 128);
    rb[i] = ld16(rsb, ob + i * 64 * 2048 + 128);
  }
  __syncthreads();
  for (int kt = 0; kt < 16; ++kt) {
    const char* ldsA = lds + (kt & 1) * 256 * LROW;
    const char* ldsB = ldsA + 128 * LROW;
    char* nb = lds + ((kt + 1) & 1) * 256 * LROW;
    const bool st = (kt + 1 < 16), ldn = (kt + 2 < 16);
#pragma unroll
    for (int ks = 0; ks < 4; ++ks) {
      const bf16x8 af = *(const bf16x8*)(ldsA + (32 * wm + r) * LROW + (16 * ks + 8 * h) * 2);
      bf16x8 bfr[2];
#pragma unroll
      for (int j = 0; j < 2; ++j) bfr[j] = *(const bf16x8*)(ldsB + (64 * wn + 32 * j + r) * LROW + (16 * ks + 8 * h) * 2);
#pragma unroll
      for (int j = 0; j < 2; ++j) {
        if (SWAP) acc[0][j] = MFMA(bfr[j], af, acc[0][j]);
        else acc[0][j] = MFMA(af, bfr[j], acc[0][j]);
      }
      const int i = ks >> 1;
      if ((ks & 1) == 0) {
        if (st) *(u32x4*)(nb + soff + i * 64 * LROW) = ra[i];
        if (ldn) ra[i] = ld16(rsa, oa + i * 64 * 2048 + (kt + 2) * 128);
      } else {
        if (st) *(u32x4*)(nb + 128 * LROW + soff + i * 64 * LROW) = rb[i];
        if (ldn) rb[i] = ld16(rsb, ob + i * 64 * 2048 + (kt + 2) * 128);
      }
      __builtin_amdgcn_sched_barrier(0);
    }
    __syncthreads();
  }
}

__device__ void inproj_tile(const Params& p, int l, int tile, char* lds) {
  const int tid = opaque_tid(), w = tid >> 6, lane = tid & 63, r = lane & 31, h = lane >> 5;
  const int wm = w & 3, wn = w >> 2;
  const int nt = tile % 26, mt = tile / 26;
  const int m0 = mt * 128, n0 = nt * 128;
  const bf16_t* Hb = (const bf16_t*)(p.ws + OFF_H);
  const bf16_t* Wt = (const bf16_t*)(p.ws + OFF_WIN) + (size_t)l * DIN * 1024;
  const bool isV = (nt == 3) || (nt == 9) || (nt == 16) || (nt == 17) || (nt == 23);
  const int hc = (n0 >> 6) + wn;
  f32x16 acc[1][2];
  if (isV) {
    gemm_mainloop<false>(Hb, Wt, m0, n0, lds, acc);
    bf16_t* dst; int nh, vh;
    if (hc < 8) { dst = (bf16_t*)(p.ws + OFF_VA); nh = 2; vh = hc - 6; }
    else if (hc < 20) { dst = (bf16_t*)(p.ws + OFF_VB); nh = 2; vh = hc - 18; }
    else if (hc < 36) { dst = (bf16_t*)(p.ws + OFF_VC); nh = 4; vh = hc - 32; }
    else { dst = (bf16_t*)(p.ws + OFF_VD); nh = 2; vh = hc - 46; }
    const int b = m0 >> 13, s0 = (m0 & 8191) + 32 * wm;
#pragma unroll
    for (int i = 0; i < 1; ++i)
#pragma unroll
      for (int j = 0; j < 2; ++j) {
        const int d = 32 * j + r;
        bf16_t* row = dst + ((size_t)(b * nh + vh) * 64 + d) * SEQ + s0 + 32 * i + 4 * h;
#pragma unroll
        for (int g = 0; g < 4; ++g) {
          u32x2 o;
          o[0] = pk2(acc[i][j][4 * g + 0], acc[i][j][4 * g + 1]);
          o[1] = pk2(acc[i][j][4 * g + 2], acc[i][j][4 * g + 3]);
          *(u32x2*)(row + 8 * g) = o;
        }
      }
    return;
  }
  gemm_mainloop<true>(Hb, Wt, m0, n0, lds, acc);
  int branch, idx;
  if (hc < 12) { branch = 0; idx = hc; }
  else if (hc < 24) { branch = 1; idx = hc - 12; }
  else if (hc < 40) { branch = 2; idx = hc - 24; }
  else { branch = 3; idx = hc - 40; }
  int kind, head;
  if (branch == 2) {
    if (idx < 4) { kind = 0; head = idx; } else if (idx < 8) { kind = 1; head = idx - 4; } else { kind = 3; head = idx - 12; }
  } else {
    if (idx < 4) { kind = 0; head = idx; } else if (idx < 6) { kind = 1; head = idx - 4; } else { kind = 3; head = idx - 8; }
  }
  constexpr int RROW = 272;
  const bool needs_rope = (kind != 3) && (branch != 2);
  if (needs_rope) {
    const int s0 = m0 & 8191;
    const __amdgpu_buffer_rsrc_t rst = mk_rsrc(p.ws + OFF_T32);
    if (branch == 0) {
      for (int idx = tid; idx < 66 * 16; idx += 512) {
        const int row = idx >> 4, c = idx & 15;
        const int pos = row < 64 ? row : (s0 >> 6) + (row - 64);
        *(u32x4*)(lds + row * RROW + c * 16) = ld16(rst, (size_t)(pos * 16 + c) * 16);
      }
      if (tid < 64) ((float*)(lds + 66 * RROW))[tid] = (kind == 0 ? p.qn_a : p.kn_a)[l * 64 + tid];
    } else {
      for (int idx = tid; idx < 128 * 16; idx += 512) {
        const int row = idx >> 4, c = idx & 15;
        *(u32x4*)(lds + row * RROW + c * 16) = ld16(rst, (size_t)((s0 + row) * 16 + c) * 16);
      }
    }
    __syncthreads();
  }
  const float* gl = (const float*)(lds + 66 * RROW);
#pragma unroll
  for (int i = 0; i < 1; ++i) {
    const int token = m0 + 32 * wm + r;
    const int tl = 32 * wm + r;
    const int b = token >> 13, s = token & 8191;
    f32x16 v0 = acc[i][0], v1 = acc[i][1];
    u32x2 pkd[2][4];
    const int token0 = m0 + 32 * wm;
    bf16_t* rowbase; int rstride;
    if (kind == 3) {
      rowbase = (bf16_t*)(p.ws + OFF_GATE) + (size_t)token0 * 1024 + branch * 256 + head * 64; rstride = 1024;
#pragma unroll
      for (int g = 0; g < 4; ++g) {
        float t[8];
#pragma unroll
        for (int e = 0; e < 4; ++e) {
          const float a0 = v0[4 * g + e], a1 = v1[4 * g + e];
          t[e] = a0 * __builtin_amdgcn_rcpf(1.f + __builtin_amdgcn_exp2f(-a0 * LOG2E));
          t[4 + e] = a1 * __builtin_amdgcn_rcpf(1.f + __builtin_amdgcn_exp2f(-a1 * LOG2E));
        }
        u32x2 o0, o1;
        o0[0] = pk2(t[0], t[1]); o0[1] = pk2(t[2], t[3]);
        o1[0] = pk2(t[4], t[5]); o1[1] = pk2(t[6], t[7]);
        pkd[0][g] = o0; pkd[1][g] = o1;
      }
    } else {
    if (branch == 0) {
      float ss = 0.f;
#pragma unroll
      for (int e = 0; e < 16; ++e) ss += v0[e] * v0[e] + v1[e] * v1[e];
      ss += xor32(ss);
      const float rstd = rsqrtf(ss * (1.f / 64.f) + EPSV);
#pragma unroll
      for (int e = 0; e < 16; ++e) {
        v0[e] = v0[e] * rstd * gl[crow(e, h)];
        v1[e] = v1[e] * rstd * gl[32 + crow(e, h)];
      }
    }
    if (branch == 0 || branch == 3) {
      const int row0 = (branch == 0) ? (64 + (tl >> 6)) : tl;
      const int row1 = (branch == 0) ? (tl & 63) : tl;
#pragma unroll
      for (int e = 0; e < 8; ++e) {
        const int jf = crow(e, h);
        const float2 c0 = *(const float2*)(lds + row0 * RROW + jf * 16);
        const float2 c1 = *(const float2*)(lds + row1 * RROW + jf * 16);
        const float a1 = v0[e], a2 = v0[e + 8];
        v0[e] = a1 * c0.x - a2 * c0.y; v0[e + 8] = a2 * c0.x + a1 * c0.y;
        const float b1 = v1[e], b2 = v1[e + 8];
        v1[e] = b1 * c1.x - b2 * c1.y; v1[e + 8] = b2 * c1.x + b1 * c1.y;
      }
    } else if (branch == 1) {
#pragma unroll
      for (int e = 0; e < 16; ++e) {
        const int jf = crow(e, h);
        const float2 c = *(const float2*)(lds + tl * RROW + jf * 8);
        const float a1 = v0[e], a2 = v1[e];
        v0[e] = a1 * c.x - a2 * c.y; v1[e] = a2 * c.x + a1 * c.y;
      }
    }
    float sc = 1.f;
    if (kind == 0) sc = (branch == 3) ? (0.17677669529663687f * LOG2E) : (0.125f * LOG2E);
    const int b0 = token0 >> 13, s0w = token0 & 8191;
    if (kind == 0) {
      const size_t qoff = (branch == 0) ? OFF_QA : (branch == 1) ? OFF_QB : (branch == 2) ? OFF_QC : OFF_QD;
      rowbase = (bf16_t*)(p.ws + qoff) + ((size_t)(b0 * 4 + head) * SEQ + s0w) * 64;
    } else {
      const size_t koff = (branch == 0) ? OFF_KA : (branch == 1) ? OFF_KB : (branch == 2) ? OFF_KC : OFF_KD;
      const int nh = (branch == 2) ? 4 : 2;
      rowbase = (bf16_t*)(p.ws + koff) + ((size_t)(b0 * nh + head) * SEQ + s0w) * 64;
    }
    rstride = 64;
#pragma unroll
    for (int g = 0; g < 4; ++g) {
      u32x2 o0, o1;
      o0[0] = pk2(v0[4 * g] * sc, v0[4 * g + 1] * sc); o0[1] = pk2(v0[4 * g + 2] * sc, v0[4 * g + 3] * sc);
      o1[0] = pk2(v1[4 * g] * sc, v1[4 * g + 1] * sc); o1[1] = pk2(v1[4 * g + 2] * sc, v1[4 * g + 3] * sc);
      pkd[0][g] = o0; pkd[1][g] = o1;
    }
    }
    char* slab = lds + 36864 + w * 4608;
#pragma unroll
    for (int j = 0; j < 2; ++j)
#pragma unroll
      for (int g = 0; g < 4; ++g) *(u32x2*)(slab + r * 144 + (32 * j + 8 * g + 4 * h) * 2) = pkd[j][g];
    asm volatile("s_waitcnt lgkmcnt(0)" ::: "memory");
#pragma unroll
    for (int it = 0; it < 4; ++it) {
      const int row = (lane >> 3) + 8 * it, c = lane & 7;
      const u32x4 vv = *(const u32x4*)(slab + row * 144 + c * 16);
      *(u32x4*)(rowbase + (size_t)row * rstride + c * 8) = vv;
    }
  }
}

__device__ void outproj_tile(const Params& p, int l, int tile, char* lds, const float* __restrict__ xin, float* __restrict__ xout) {
  const int tid = opaque_tid(), w = tid >> 6, lane = tid & 63, r = lane & 31, h = lane >> 5;
  const int wm = w & 3, wn = w >> 2;
  const int nt = tile & 7, mt = tile >> 3;
  const int m0 = mt * 128, n0 = nt * 128;
  const bf16_t* Mx = (const bf16_t*)(p.ws + OFF_MIX);
  const bf16_t* Wt = (const bf16_t*)(p.ws + OFF_WOUT) + (size_t)l * 1024 * 1024;
  f32x16 acc[1][2];
  const __amdgpu_buffer_rsrc_t rsxin = mk_rsrc(xin);
  gemm_mainloop<false>(Mx, Wt, m0, n0, lds, acc);
#pragma unroll
  for (int i = 0; i < 1; ++i)
#pragma unroll
    for (int j = 0; j < 2; ++j) {
      const int n = n0 + 64 * wn + 32 * j + r;
#pragma unroll
      for (int e = 0; e < 16; ++e) {
        const int m = m0 + 32 * wm + crow(e, h);
        const size_t o = (size_t)m * DM + n;
        xout[o] = __uint_as_float(ld4(rsxin, o * 4)) + acc[i][j][e];
      }
    }
}

enum { MA = 0, MB = 1, MC = 2, MD = 3 };

template <int MODE>
__device__ void attn_item(const Params& p, int l, int item, char* lds) {
  const int tid = opaque_tid(), w = tid >> 6, lane = tid & 63, r = lane & 31, h = lane >> 5;
  const int qg = w & 3, role = w >> 2;
  constexpr int NKS = (MODE == MD) ? 2 : 4;
  constexpr bool FAST = (MODE == MA || MODE == MD);
  constexpr bool NEGM = FAST;
  constexpr float P_THR = 256.f;
  float* ldsR = (float*)(lds + 256 * LROW);

  int b, qtok, ktlo, kthi, head_out, koff = 0;
  const bf16_t *Qp, *Kg, *Vg;
  int qrow = 0, rs = 0, qcol0 = 0;
  if (MODE == MA || MODE == MB) {
    b = item >> 7; const int kvh = (item >> 6) & 1, qb = item & 63;
    qtok = qb * 128 + 32 * qg + r;
    head_out = kvh * 2 + role;
    Qp = (const bf16_t*)(p.ws + (MODE == MA ? OFF_QA : OFF_QB)) + ((size_t)(b * 4 + head_out) * SEQ + qtok) * 64 + 8 * h;
    const int kvrow = b * 2 + kvh;
    Kg = (const bf16_t*)(p.ws + (MODE == MA ? OFF_KA : OFF_KB)) + (size_t)kvrow * SEQ * 64;
    Vg = (const bf16_t*)(p.ws + (MODE == MA ? OFF_VA : OFF_VB)) + (size_t)kvrow * 64 * SEQ;
    if (MODE == MA) { ktlo = 0; kthi = 128; }
    else { ktlo = max(0, qb * 2 - 2); kthi = min(128, qb * 2 + 4); }
  } else if (MODE == MD) {
    b = item >> 8; const int hq = (item >> 6) & 3, qb = item & 63;
    qtok = qb * 128 + 32 * qg + r;
    head_out = hq;
    koff = 32 * role;
    Qp = (const bf16_t*)(p.ws + OFF_QD) + ((size_t)(b * 4 + hq) * SEQ + qtok) * 64 + koff + 8 * h;
    const int kvrow = b * 2 + (hq >> 1);
    Kg = (const bf16_t*)(p.ws + OFF_KD) + (size_t)kvrow * SEQ * 64;
    Vg = (const bf16_t*)(p.ws + OFF_VD) + (size_t)kvrow * 64 * SEQ;
    ktlo = 0; kthi = 128;
  } else {
    b = item >> 7; const int hh = (item >> 5) & 3, rg = item & 31;
    qrow = rg * 4 + qg;
    rs = min(max(qrow - 4, 0), 120);
    qcol0 = 32 * role;
    qtok = qrow * 64 + qcol0 + r;
    head_out = hh;
    Qp = (const bf16_t*)(p.ws + OFF_QC) + ((size_t)(b * 4 + hh) * SEQ + qtok) * 64 + 8 * h;
    const int kvrow = b * 4 + hh;
    Kg = (const bf16_t*)(p.ws + OFF_KC) + (size_t)kvrow * SEQ * 64;
    Vg = (const bf16_t*)(p.ws + OFF_VC) + (size_t)kvrow * 64 * SEQ;
    ktlo = min(max(rg * 4 - 4, 0), 120);
    kthi = min(max(rg * 4 + 3 - 4, 0), 120) + 8;
    const float* rp = p.rpb_c + ((size_t)l * 4 + hh) * 465;
    for (int i = tid; i < 465; i += 512) ldsR[i] = rp[i] * LOG2E;
  }

  const __amdgpu_buffer_rsrc_t rsw = mk_rsrc(p.ws);
  bf16x8 qf[NKS];
#pragma unroll
  for (int ks = 0; ks < NKS; ++ks) qf[ks] = __builtin_bit_cast(bf16x8, ld16(rsw, (size_t)((const char*)(Qp + 16 * ks) - p.ws)));

  f32x16 O[2];
#pragma unroll
  for (int db = 0; db < 2; ++db)
#pragma unroll
    for (int e = 0; e < 16; ++e) O[db][e] = 0.f;
  float mrun, lrun;
  if (MODE == MB) { mrun = p.sink_b[l * 4 + head_out] * LOG2E; lrun = 0.5f; }
  else { mrun = NEG; lrun = 0.f; }
  f32x16 negm;
  if (FAST) {
    f32x16 s0;
#pragma unroll
    for (int e = 0; e < 16; ++e) s0[e] = 0.f;
#pragma unroll
    for (int ks = 0; ks < NKS; ++ks) {
      const bf16_t* kp = Kg + ((size_t)ktlo * 64 + r) * 64 + koff + 16 * ks + 8 * h;
      const bf16x8 k0 = __builtin_bit_cast(bf16x8, ld16(rsw, (size_t)((const char*)kp - p.ws)));
      s0 = MFMA(k0, qf[ks], s0);
    }
    float m0 = s0[0];
#pragma unroll
    for (int e = 1; e < 16; ++e) m0 = fmaxf(m0, s0[e]);
    m0 = fmaxf(m0, xor32(m0));
    mrun = m0;
#pragma unroll
    for (int e = 0; e < 16; ++e) negm[e] = -m0;
  }
  u32x4 kreg, vreg;
  const int lrow = tid >> 3, lch = tid & 7;
  const bf16_t* kgp = Kg + (size_t)lrow * 64 + lch * 8;
  const bf16_t* vgp = Vg + (size_t)lrow * SEQ + lch * 8;
  kreg = ld16(rsw, (size_t)((const char*)(kgp + (size_t)ktlo * 64 * 64) - p.ws));
  vreg = ld16(rsw, (size_t)((const char*)(vgp + ktlo * 64) - p.ws));
  const int soff = lrow * LROW + lch * 16;
  const int vsoff = lrow * LROW + (lch >> 1) * 32 + (lch & 1) * 8;

  __syncthreads();
  *(u32x4*)(lds + soff) = kreg;
  { u32x2 lo_ = {vreg[0], vreg[1]}, hi_ = {vreg[2], vreg[3]}; *(u32x2*)(lds + 64 * LROW + vsoff) = lo_; *(u32x2*)(lds + 64 * LROW + vsoff + 16) = hi_; }
  if (ktlo + 1 < kthi) {
    kreg = ld16(rsw, (size_t)((const char*)(kgp + (size_t)(ktlo + 1) * 64 * 64) - p.ws));
    vreg = ld16(rsw, (size_t)((const char*)(vgp + (ktlo + 1) * 64) - p.ws));
  }
  __syncthreads();
  for (int kt = ktlo; kt < kthi; ++kt) {
    const int cur = (kt - ktlo) & 1;
    const char* ldsK = lds + cur * 128 * LROW;
    const char* ldsV = ldsK + 64 * LROW;
    if (kt + 1 < kthi) {
      char* nb = lds + (cur ^ 1) * 128 * LROW;
      *(u32x4*)(nb + soff) = kreg;
      { u32x2 lo_ = {vreg[0], vreg[1]}, hi_ = {vreg[2], vreg[3]}; *(u32x2*)(nb + 64 * LROW + vsoff) = lo_; *(u32x2*)(nb + 64 * LROW + vsoff + 16) = hi_; }
    }
    if (kt + 2 < kthi) {
      kreg = ld16(rsw, (size_t)((const char*)(kgp + (size_t)(kt + 2) * 64 * 64) - p.ws));
      vreg = ld16(rsw, (size_t)((const char*)(vgp + (kt + 2) * 64) - p.ws));
    }
    bool active = true;
    if (MODE == MC) active = (kt >= rs) && (kt < rs + 8);
    if (active) {
#pragma nounroll
      for (int kb = 0; kb < 2; ++kb) {
        bf16x8 pf[2];
        if (FAST) {
          f32x16 S = negm;
#pragma unroll
          for (int ks = 0; ks < NKS; ++ks) {
            const bf16x8 k0 = *(const bf16x8*)(ldsK + (32 * kb + r) * LROW + (koff + 16 * ks + 8 * h) * 2);
            S = MFMA(k0, qf[ks], S);
          }
          float ls = 0.f;
#pragma unroll
          for (int e = 0; e < 16; ++e) { S[e] = __builtin_amdgcn_exp2f(S[e]); ls += S[e]; }
          if (__any(!(ls <= P_THR))) {
            S = negm;
#pragma unroll
            for (int ks = 0; ks < NKS; ++ks) {
              const bf16x8 k0 = *(const bf16x8*)(ldsK + (32 * kb + r) * LROW + (koff + 16 * ks + 8 * h) * 2);
              S = MFMA(k0, qf[ks], S);
            }
            float mx = S[0];
#pragma unroll
            for (int e = 1; e < 16; ++e) mx = fmaxf(mx, S[e]);
            mx = fmaxf(mx, xor32(mx));
            const float d = fmaxf(mx, 0.f);
            const float alpha = __builtin_amdgcn_exp2f(-d);
            mrun += d;
            lrun *= alpha;
#pragma unroll
            for (int db = 0; db < 2; ++db)
#pragma unroll
              for (int e = 0; e < 16; ++e) O[db][e] *= alpha;
#pragma unroll
            for (int e = 0; e < 16; ++e) negm[e] -= d;
            ls = 0.f;
#pragma unroll
            for (int e = 0; e < 16; ++e) { S[e] = __builtin_amdgcn_exp2f(S[e] - d); ls += S[e]; }
          }
#pragma unroll
          for (int s = 0; s < 2; ++s) {
            u32x4 pk;
            pk[0] = pk2(S[8 * s + 0], S[8 * s + 1]); pk[1] = pk2(S[8 * s + 2], S[8 * s + 3]);
            pk[2] = pk2(S[8 * s + 4], S[8 * s + 5]); pk[3] = pk2(S[8 * s + 6], S[8 * s + 7]);
            pf[s] = __builtin_bit_cast(bf16x8, pk);
          }
          lrun += ls;
        } else {
          f32x16 S;
#pragma unroll
          for (int e = 0; e < 16; ++e) S[e] = 0.f;
#pragma unroll
          for (int ks = 0; ks < NKS; ++ks) {
            const bf16x8 k0 = *(const bf16x8*)(ldsK + (32 * kb + r) * LROW + (16 * ks + 8 * h) * 2);
            S = MFMA(k0, qf[ks], S);
          }
          if (MODE == MB) {
#pragma unroll
            for (int e = 0; e < 16; ++e) {
              const int kpos = kt * 64 + 32 * kb + crow(e, h);
              const int dlt = qtok - kpos;
              const bool ok = (dlt <= 128) && (dlt >= -128);
              S[e] = ok ? S[e] : NEG;
            }
          }
          if (MODE == MC) {
            const int dr = kt - qrow + 7;
            const int qcol = qcol0 + r;
            const int cs = min(max(qcol - 8, 0), 48);
#pragma unroll
            for (int e = 0; e < 16; ++e) {
              const int kcol = 32 * kb + crow(e, h);
              const bool ok = (kcol >= cs) && (kcol < cs + 16);
              const int dc = min(max(kcol - qcol, -15), 15) + 15;
              const float bias = ldsR[dr * 31 + dc];
              S[e] = ok ? (S[e] + bias) : NEG;
            }
          }
          float mx = S[0];
#pragma unroll
          for (int e = 1; e < 16; ++e) mx = fmaxf(mx, S[e]);
          mx = fmaxf(mx, xor32(mx));
          if (__any(mx > mrun)) {
            const float mn = fmaxf(mrun, mx);
            const float alpha = __builtin_amdgcn_exp2f(mrun - mn);
            mrun = mn;
            lrun *= alpha;
#pragma unroll
            for (int db = 0; db < 2; ++db)
#pragma unroll
              for (int e = 0; e < 16; ++e) O[db][e] *= alpha;
          }
          const float mn = mrun;
          float ls = 0.f;
#pragma unroll
          for (int e = 0; e < 16; ++e) {
            const float pvv = __builtin_amdgcn_exp2f(S[e] - mn);
            S[e] = pvv;
            ls += pvv;
          }
          lrun += ls;
#pragma unroll
          for (int s = 0; s < 2; ++s) {
            u32x4 pk;
            pk[0] = pk2(S[8 * s + 0], S[8 * s + 1]); pk[1] = pk2(S[8 * s + 2], S[8 * s + 3]);
            pk[2] = pk2(S[8 * s + 4], S[8 * s + 5]); pk[3] = pk2(S[8 * s + 6], S[8 * s + 7]);
            pf[s] = __builtin_bit_cast(bf16x8, pk);
          }
        }
#pragma unroll
        for (int s = 0; s < 2; ++s)
#pragma unroll
          for (int db = 0; db < 2; ++db) {
            const bf16x8 vf = *(const bf16x8*)(ldsV + (32 * db + r) * LROW + (32 * kb + 16 * s) * 2 + 16 * h);
            O[db] = MFMA(vf, pf[s], O[db]);
          }
      }
    }
    __syncthreads();
  }

  bf16_t* mix = (bf16_t*)(p.ws + OFF_MIX);
  lrun += xor32(lrun);
  const float inv = 1.f / lrun;
  if (MODE == MD) {
    float* xch = (float*)lds + (size_t)qg * 32 * 64 + lane;
    __syncthreads();
    if (role == 1) {
#pragma unroll
      for (int db = 0; db < 2; ++db)
#pragma unroll
        for (int e = 0; e < 16; ++e) xch[(db * 16 + e) * 64] = O[db][e] * inv;
    }
    __syncthreads();
    if (role == 1) return;
    const float lam = __uint_as_float(ld4(rsw, OFF_CTRL + (16 + l * 2 + 0) * 4)), omli = __uint_as_float(ld4(rsw, OFF_CTRL + (16 + l * 2 + 1) * 4));
    f32x16 o[2];
    float ss = 0.f;
#pragma unroll
    for (int db = 0; db < 2; ++db)
#pragma unroll
      for (int e = 0; e < 16; ++e) {
        const float t = O[db][e] * inv - lam * xch[(db * 16 + e) * 64];
        o[db][e] = t;
        ss += t * t;
      }
    ss += xor32(ss);
    const float rstd = rsqrtf(ss * (1.f / 64.f) + EPSV) * omli;
    const size_t base = (size_t)(b * SEQ + qtok) * 1024 + 768 + head_out * 64 + 4 * h;
    const float* sg = p.subln + l * 64 + 4 * h;
#pragma unroll
    for (int db = 0; db < 2; ++db)
#pragma unroll
      for (int g = 0; g < 4; ++g) {
        const size_t off = base + 32 * db + 8 * g;
        const u32x2 gv = ld8(rsw, OFF_GATE + off * 2);
        const float g0 = __uint_as_float(gv[0] << 16), g1 = __uint_as_float(gv[0] & 0xffff0000u);
        const float g2 = __uint_as_float(gv[1] << 16), g3 = __uint_as_float(gv[1] & 0xffff0000u);
        const float* sgp = sg + 32 * db + 8 * g;
        u32x2 ov;
        ov[0] = pk2(o[db][4 * g + 0] * rstd * sgp[0] * g0, o[db][4 * g + 1] * rstd * sgp[1] * g1);
        ov[1] = pk2(o[db][4 * g + 2] * rstd * sgp[2] * g2, o[db][4 * g + 3] * rstd * sgp[3] * g3);
        *(u32x2*)(mix + off) = ov;
      }
  } else {
    const int brc = (MODE == MA) ? 0 : (MODE == MB) ? 256 : 512;
    const size_t base = (size_t)(b * SEQ + qtok) * 1024 + brc + head_out * 64 + 4 * h;
#pragma unroll
    for (int db = 0; db < 2; ++db)
#pragma unroll
      for (int g = 0; g < 4; ++g) {
        const size_t off = base + 32 * db + 8 * g;
        const u32x2 gv = ld8(rsw, OFF_GATE + off * 2);
        const float g0 = __uint_as_float(gv[0] << 16), g1 = __uint_as_float(gv[0] & 0xffff0000u);
        const float g2 = __uint_as_float(gv[1] << 16), g3 = __uint_as_float(gv[1] & 0xffff0000u);
        u32x2 ov;
        ov[0] = pk2(O[db][4 * g + 0] * inv * g0, O[db][4 * g + 1] * inv * g1);
        ov[1] = pk2(O[db][4 * g + 2] * inv * g2, O[db][4 * g + 3] * inv * g3);
        *(u32x2*)(mix + off) = ov;
      }
  }
}

constexpr int N_D = 512, N_A = 256, N_B = 256, N_C = 256;
constexpr int N_ATT = N_D + N_A + N_B + N_C;

__device__ void phase_prep(const Params& p, char* lds) {
  const int tid = opaque_tid();
  const int gtid = blockIdx.x * blockDim.x + tid, nth = gridDim.x * blockDim.x;
  if (blockIdx.x == 0 && tid == 0) {
    float* cf = (float*)(p.ws + OFF_CTRL) + 16;
    for (int l = 0; l < 2; ++l) {
      float s1 = 0.f, s2 = 0.f;
      for (int i = 0; i < 32; ++i) { s1 += p.lq1[l * 32 + i] * p.lk1[l * 32 + i]; s2 += p.lq2[l * 32 + i] * p.lk2[l * 32 + i]; }
      const float li = (l == 0) ? 0.2f : 0.35550906759096934f;
      cf[l * 2 + 0] = __expf(s1) - __expf(s2) + li;
      cf[l * 2 + 1] = 1.0f - li;
    }
  }
  float2* T32 = (float2*)(p.ws + OFF_T32);
  for (int i = gtid; i < SEQ * 32; i += nth) {
    const int pos = i >> 5, j = i & 31;
    const float ang = (float)pos * INV32[j];
    float sn, cs;
    sincos_d(ang, sn, cs);
    T32[i] = make_float2(cs, sn);
  }
  const int half = tid >> 8, tl = tid & 255;
  for (int tp = blockIdx.x; tp < 832 + 256; tp += gridDim.x) {
    const int t = 2 * tp + half;
    const int l = t / 1088, tt = t % 1088;
    float* lf = (float*)(lds + half * 20480);
    if (tt < 832) wconv_tile(p.w_in + (size_t)l * 1024 * DIN, p.norm_g + l * 1024, (bf16_t*)(p.ws + OFF_WIN) + (size_t)l * DIN * 1024, DIN, tt, lf, tl);
    else wconv_tile(p.w_out + (size_t)l * 1024 * 1024, nullptr, (bf16_t*)(p.ws + OFF_WOUT) + (size_t)l * 1024 * 1024, 1024, tt - 832, lf, tl);
  }
  rms_rows<false>(p.x, (bf16_t*)(p.ws + OFF_H), nullptr, nullptr);
}

__device__ void phase_inproj(const Params& p, int l, char* lds) {
  if ((gridDim.x & 7) == 0) {
    const int xcd = blockIdx.x & 7, slot = blockIdx.x >> 3, slots = gridDim.x >> 3;
    for (int q = slot; q < 16 * 26; q += slots) {
      int mtl, nt;
      if (q < 384) { const int ng = q >> 7, rem = q & 127, w8 = rem & 63; mtl = (rem >> 6) * 8 + (w8 & 7); nt = ng * 8 + (w8 >> 3); }
      else { const int rem = q - 384; mtl = rem & 15; nt = 24 + (rem >> 4); }
      inproj_tile(p, l, (xcd * 16 + mtl) * 26 + nt, lds);
    }
  } else {
    for (int t = blockIdx.x; t < 128 * 26; t += gridDim.x) inproj_tile(p, l, t, lds);
  }
}

DI int fetch_item(unsigned* ctr, int* s_item) {
  __syncthreads();
  if (threadIdx.x == 0) *s_item = (int)atomicAdd(ctr, 1u);
  __syncthreads();
  return *s_item;
}

__device__ void phase_attn(const Params& p, int l, char* lds, int* s_item, int cidx) {
  unsigned* ctr = (unsigned*)(p.ws + OFF_CTRL) + cidx;
  int item = blockIdx.x;
  while (item < N_A) { attn_item<MA>(p, l, item, lds); item = (int)gridDim.x + fetch_item(ctr, s_item); }
  while (item < N_A + N_D) { attn_item<MD>(p, l, item - N_A, lds); item = (int)gridDim.x + fetch_item(ctr, s_item); }
  while (item < N_A + N_D + N_B) { attn_item<MB>(p, l, item - N_A - N_D, lds); item = (int)gridDim.x + fetch_item(ctr, s_item); }
  while (item < N_ATT) { attn_item<MC>(p, l, item - N_A - N_D - N_B, lds); item = (int)gridDim.x + fetch_item(ctr, s_item); }
}

__device__ void phase_outproj(const Params& p, int l, char* lds) {
  const float* xin = (l == 0) ? p.x : (const float*)(p.ws + OFF_X1);
  float* xout = (l == 0) ? (float*)(p.ws + OFF_X1) : p.out;
  if ((gridDim.x & 7) == 0) {
    const int xcd = blockIdx.x & 7, slot = blockIdx.x >> 3, slots = gridDim.x >> 3;
    for (int q = slot; q < 16 * 8; q += slots) {
      const int w8 = q & 63, mtl = (q >> 6) * 8 + (w8 & 7), nt = w8 >> 3;
      outproj_tile(p, l, (xcd * 16 + mtl) * 8 + nt, lds, xin, xout);
    }
  } else {
    for (int t = blockIdx.x; t < 128 * 8; t += gridDim.x) outproj_tile(p, l, t, lds, xin, xout);
  }
}

__global__ void __launch_bounds__(512, 4) fwd_megakernel(Params p) {
  __shared__ __attribute__((aligned(16))) char lds[4 * 128 * LROW];
  __shared__ int s_item;
  __shared__ uint4 xb_words;
  if (p.ws == nullptr) cg::this_grid().sync();
  if (threadIdx.x == 0) xb_words = make_uint4(0u, 0u, 0u, 0u);
  __syncthreads();
  XcdBarrier gb = xcd_barrier_post((unsigned*)(p.ws + OFF_BAR), (volatile LAS unsigned*)&xb_words);
  phase_prep(p, lds);
  xcd_barrier(gb);
  for (int l = 0; l < 2; ++l) {
    phase_inproj(p, l, lds);
    xcd_barrier(gb);
    phase_attn(p, l, lds, &s_item, l);
    xcd_barrier(gb);
#ifdef PROBE_ATTN2
    phase_attn(p, l, lds, &s_item, l + 2);
    xcd_barrier(gb);
#endif
#ifdef PROBE_GEMM2
    phase_inproj(p, l, lds);
    xcd_barrier(gb);
#endif
    phase_outproj(p, l, lds);
    xcd_barrier(gb);
    if (l == 0) {
      rms_rows<false>((const float*)(p.ws + OFF_X1), (bf16_t*)(p.ws + OFF_H), nullptr, nullptr);
      xcd_barrier(gb);
    } else {
      rms_rows<true>(p.out, nullptr, p.out, p.final_g);
    }
  }
}

extern "C" void kernel_launch(void* const* d_in, const int* in_sizes, int n_in, void* d_out,
                              int out_size, void* d_ws, size_t ws_size, hipStream_t stream) {
  static int grid_blocks = 0;
  if (!grid_blocks) {
    int dev = 0, cus = 0, per_cu = 0;
    (void)hipGetDevice(&dev);
    (void)hipDeviceGetAttribute(&cus, hipDeviceAttributeMultiprocessorCount, dev);
    (void)hipOccupancyMaxActiveBlocksPerMultiprocessor(&per_cu, fwd_megakernel, 512, 0);
    if (per_cu > 2) per_cu = 2;
    if (per_cu < 1) per_cu = 1;
    grid_blocks = cus * per_cu;
  }
  if (ws_size < WS_NEEDED) { fprintf(stderr, "workspace too small\n"); return; }
  Params p{};
  p.x = (const float*)d_in[0]; p.norm_g = (const float*)d_in[1]; p.w_in = (const float*)d_in[2]; p.w_out = (const float*)d_in[3];
  p.qn_a = (const float*)d_in[4]; p.kn_a = (const float*)d_in[5]; p.sink_b = (const float*)d_in[6]; p.rpb_c = (const float*)d_in[7];
  p.lq1 = (const float*)d_in[8]; p.lk1 = (const float*)d_in[9]; p.lq2 = (const float*)d_in[10]; p.lk2 = (const float*)d_in[11];
  p.subln = (const float*)d_in[12]; p.final_g = (const float*)d_in[13];
  p.out = (float*)d_out; p.ws = (char*)d_ws;
  (void)hipMemsetAsync(d_ws, 0, OFF_T32, stream);
  void* args[] = {&p};
  hipError_t e = hipLaunchCooperativeKernel((void*)fwd_megakernel, dim3(grid_blocks), dim3(512), args, 0, stream);
  if (e != hipSuccess) fprintf(stderr, "cooperative launch failed: %s (grid %d)\n", hipGetErrorString(e), grid_blocks);
}
```

```cpp
#include <hip/hip_runtime.h>
#include <hip/hip_cooperative_groups.h>
#include <cstdio>
#include <cstdint>
namespace cg = cooperative_groups;

#define DI __device__ __forceinline__
typedef unsigned short bf16_t;
typedef short bf16x8 __attribute__((ext_vector_type(8)));
typedef short s16x4 __attribute__((ext_vector_type(4)));
typedef float f32x16 __attribute__((ext_vector_type(16)));
typedef float f32x4 __attribute__((ext_vector_type(4)));
typedef float f32x2 __attribute__((ext_vector_type(2)));
typedef __bf16 bf16x2_t __attribute__((ext_vector_type(2)));
typedef unsigned u32x2 __attribute__((ext_vector_type(2)));
typedef unsigned u32x4 __attribute__((ext_vector_type(4)));

#define MFMA(a, b, c) __builtin_amdgcn_mfma_f32_32x32x16_bf16((a), (b), (c), 0, 0, 0)

constexpr int SEQ = 8192, DM = 1024, DIN = 3328, MTOK = 16384;
constexpr float LOG2E = 1.4426950408889634f;
constexpr float EPSV = 1e-6f;
constexpr float NEG = -1e30f;

constexpr size_t MiB = 1024 * 1024;
constexpr size_t OFF_BAR = 0;
constexpr size_t OFF_CTRL = 16384;
constexpr size_t OFF_T32 = 20480;
constexpr size_t OFF_WIN = OFF_T32 + 2 * MiB;
constexpr size_t OFF_WOUT = OFF_WIN + 13 * MiB;
constexpr size_t OFF_H = OFF_WOUT + 4 * MiB;
constexpr size_t OFF_QA = OFF_H + 32 * MiB;
constexpr size_t OFF_KA = OFF_QA + 8 * MiB;
constexpr size_t OFF_VA = OFF_KA + 4 * MiB;
constexpr size_t OFF_QB = OFF_VA + 4 * MiB;
constexpr size_t OFF_KB = OFF_QB + 8 * MiB;
constexpr size_t OFF_VB = OFF_KB + 4 * MiB;
constexpr size_t OFF_QC = OFF_VB + 4 * MiB;
constexpr size_t OFF_KC = OFF_QC + 8 * MiB;
constexpr size_t OFF_VC = OFF_KC + 8 * MiB;
constexpr size_t OFF_QD = OFF_VC + 8 * MiB;
constexpr size_t OFF_KD = OFF_QD + 8 * MiB;
constexpr size_t OFF_VD = OFF_KD + 4 * MiB;
constexpr size_t OFF_GATE = OFF_VD + 4 * MiB;
constexpr size_t OFF_X1 = OFF_GATE + 32 * MiB;
constexpr size_t OFF_MIX = OFF_X1 + 64 * MiB;
constexpr size_t WS_NEEDED = OFF_MIX + 32 * MiB;

struct Params {
  const float *x, *norm_g, *w_in, *w_out, *qn_a, *kn_a, *sink_b, *rpb_c, *lq1, *lk1, *lq2, *lk2, *subln, *final_g;
  float* out;
  char* ws;
};

__device__ const float INV32[32] = {
    1.000000000e+00f, 7.498942614e-01f, 5.623413324e-01f, 4.216965139e-01f, 3.162277639e-01f, 2.371373773e-01f,
    1.778279394e-01f, 1.333521307e-01f, 1.000000015e-01f, 7.498941571e-02f, 5.623413250e-02f, 4.216965288e-02f,
    3.162277490e-02f, 2.371373773e-02f, 1.778279431e-02f, 1.333521493e-02f, 9.999999776e-03f, 7.498941850e-03f,
    5.623413250e-03f, 4.216964822e-03f, 3.162277630e-03f, 2.371373586e-03f, 1.778279431e-03f, 1.333521446e-03f,
    1.000000047e-03f, 7.498942432e-04f, 5.623413017e-04f, 4.216965172e-04f, 3.162277571e-04f, 2.371373703e-04f,
    1.778279402e-04f, 1.333521504e-04f};

DI unsigned pk2(float a, float b) {
  f32x2 v = {a, b};
  return __builtin_bit_cast(unsigned, __builtin_convertvector(v, bf16x2_t));
}
DI float bf2f(unsigned short u) { return __uint_as_float(((unsigned)u) << 16); }
DI int crow(int reg, int h) { return (reg & 3) + 8 * (reg >> 2) + 4 * h; }
DI float xor32(float v) { return __shfl_xor(v, 32); }
DI __amdgpu_buffer_rsrc_t mk_rsrc(const void* base) { return __builtin_amdgcn_make_buffer_rsrc((void*)base, 0, 0x7fffffff, 0x00020000); }
DI u32x4 ld16(__amdgpu_buffer_rsrc_t rs, size_t byte_off) { return __builtin_amdgcn_raw_buffer_load_b128(rs, (int)(unsigned)byte_off, 0, 16); }
DI u32x2 ld8(__amdgpu_buffer_rsrc_t rs, size_t byte_off) { return __builtin_amdgcn_raw_buffer_load_b64(rs, (int)(unsigned)byte_off, 0, 16); }
DI unsigned ld4(__amdgpu_buffer_rsrc_t rs, size_t byte_off) { return __builtin_amdgcn_raw_buffer_load_b32(rs, (int)(unsigned)byte_off, 0, 16); }
DI int opaque_tid() { int t = threadIdx.x; asm volatile("" : "+v"(t)); return t; }


#define XB_TMO      128
#define XB_XCNT(j)  (256  + 64 * (j))
#define XB_XSUB(j)  (1280 + 64 * (j))
#define XB_XGEN(j)  (2304 + 64 * (j))
#define XB_TOP      3328
#define XB_TOPGEN   3392
#define XCD_BAR_WORDS 3456
#define XB_SPIN_CAP (1u << 20)
#define LAS __attribute__((address_space(3)))
DI unsigned xb_ld(unsigned* p) { return __hip_atomic_load(p, __ATOMIC_RELAXED, __HIP_MEMORY_SCOPE_AGENT); }
DI unsigned xb_add(unsigned* p, unsigned v) { return __hip_atomic_fetch_add(p, v, __ATOMIC_RELAXED, __HIP_MEMORY_SCOPE_AGENT); }
DI unsigned xb_xcc_id() { return (unsigned)__builtin_amdgcn_s_getreg((3 << 11) | 20) & 0xFu; }
#define XB_SPIN(cond, bar) do { unsigned _sp = 0; while (cond) { __builtin_amdgcn_s_sleep(1); \
    if ((++_sp & 255u) == 0u) { if (xb_ld(&(bar)[XB_TMO])) break; if (_sp > XB_SPIN_CAP) { atomicAdd(&(bar)[XB_TMO], 1u); break; } } } } while (0)
struct XcdBarrier { unsigned* bar; unsigned x; volatile LAS unsigned* st; };
DI XcdBarrier xcd_barrier_post(unsigned* bar, volatile LAS unsigned* st) {
  XcdBarrier b; b.bar = bar; b.x = xb_xcc_id(); b.st = st;
  if (threadIdx.x == 0) (void)xb_add(&bar[XB_XCNT(b.x)], 1u);
  return b;
}
DI void xcd_barrier_complete(unsigned* bar, unsigned x, unsigned& nloc, unsigned& nx) {
  const unsigned G = gridDim.x * gridDim.y * gridDim.z;
  unsigned sum, cnt, mine, sp = 0u;
  for (;;) {
    sum = 0u; cnt = 0u; mine = 0u;
#pragma unroll
    for (unsigned j = 0; j < 16; ++j) { const unsigned c = xb_ld(&bar[XB_XCNT(j)]); sum += c; cnt += (c > 0u) ? 1u : 0u; mine = (j == x) ? c : mine; }
    if (sum == G) break;
    __builtin_amdgcn_s_sleep(1);
    if ((++sp & 255u) == 0u) { if (xb_ld(&bar[XB_TMO])) break; if (sp > XB_SPIN_CAP) { atomicAdd(&bar[XB_TMO], 1u); break; } }
  }
  nloc = mine > 0u ? mine : 1u; nx = cnt > 0u ? cnt : 1u;
}
DI void xcd_barrier(const XcdBarrier& b) {
  asm volatile("s_waitcnt vmcnt(0)" ::: "memory");
  __syncthreads();
  if (threadIdx.x == 0) {
    unsigned* bar = b.bar;
    asm volatile("" : "+s"(bar));
    __builtin_amdgcn_s_waitcnt(0);
    unsigned nloc = b.st[0], nx = b.st[1];
    if (nloc == 0u) { xcd_barrier_complete(bar, b.x, nloc, nx); b.st[0] = nloc; b.st[1] = nx; }
    unsigned bx = b.x;
    asm volatile("" : "+s"(bx));
    const unsigned old = xb_add(&bar[XB_XSUB(bx)], 1u);
    const unsigned gen = old / nloc;
    if (old + 1u == (gen + 1u) * nloc) {
      __builtin_amdgcn_fence(__ATOMIC_RELEASE, "agent");
      asm volatile("s_waitcnt vmcnt(0)" ::: "memory");
      const unsigned og = xb_add(&bar[XB_TOP], 1u);
      const unsigned tg = og / nx;
      if (og + 1u == (tg + 1u) * nx) xb_add(&bar[XB_TOPGEN], 1u);
      else XB_SPIN(xb_ld(&bar[XB_TOPGEN]) == tg, bar);
      __builtin_amdgcn_fence(__ATOMIC_ACQUIRE, "agent");
      xb_add(&bar[XB_XGEN(bx)], 1u);
      asm volatile("s_waitcnt vmcnt(0)" ::: "memory");
    } else {
      XB_SPIN(xb_ld(&bar[XB_XGEN(bx)]) == gen, bar);
      __builtin_amdgcn_fence(__ATOMIC_ACQUIRE, "agent");
      asm volatile("s_waitcnt vmcnt(0)" ::: "memory");
    }
  }
  __syncthreads();
}

DI void sincos_d(float angf, float& sn, float& cs) {
  const double a = (double)angf;
  const double q = __builtin_rint(a * 0.63661977236758134308);
  double r = __builtin_fma(-q, 1.57079632679489655800e+00, a);
  r = __builtin_fma(-q, 6.12323399573676603587e-17, r);
  const int n = ((int)q) & 3;
  const double r2 = r * r;
  double sp = 1.0 / 6227020800.0;
  sp = sp * r2 - 1.0 / 39916800.0;
  sp = sp * r2 + 1.0 / 362880.0;
  sp = sp * r2 - 1.0 / 5040.0;
  sp = sp * r2 + 1.0 / 120.0;
  sp = sp * r2 - 1.0 / 6.0;
  sp = r + r * r2 * sp;
  double cp = -1.0 / 87178291200.0;
  cp = cp * r2 + 1.0 / 479001600.0;
  cp = cp * r2 - 1.0 / 3628800.0;
  cp = cp * r2 + 1.0 / 40320.0;
  cp = cp * r2 - 1.0 / 720.0;
  cp = cp * r2 + 1.0 / 24.0;
  cp = cp * r2 - 0.5;
  cp = 1.0 + r2 * cp;
  double s_, c_;
  if (n == 0) { s_ = sp; c_ = cp; }
  else if (n == 1) { s_ = cp; c_ = -sp; }
  else if (n == 2) { s_ = -sp; c_ = -cp; }
  else { s_ = -cp; c_ = sp; }
  sn = (float)s_; cs = (float)c_;
}

__device__ void wconv_tile(const float* __restrict__ W, const float* __restrict__ g, bf16_t* __restrict__ Wt, int N, int tile, float* lds, const int tid) {
  const int ntn = N >> 6;
  const int k0 = (tile / ntn) << 6, n0 = (tile % ntn) << 6;
  __syncthreads();
#pragma unroll
  for (int i = 0; i < 16; ++i) {
    const int k = i * 4 + (tid >> 6), n = tid & 63;
    float v = W[(size_t)(k0 + k) * N + n0 + n];
    if (g) v *= g[k0 + k];
    lds[k * 65 + n] = v;
  }
  __syncthreads();
#pragma unroll
  for (int i = 0; i < 16; ++i) {
    const int n = i * 4 + (tid >> 6), k = tid & 63;
    Wt[(size_t)(n0 + n) * 1024 + k0 + k] = (bf16_t)(pk2(lds[k * 65 + n], 0.f) & 0xffffu);
  }
}

template <bool FINAL>
__device__ void rms_rows(const float* X, bf16_t* H, float* O, const float* g) {
  const int t_ = opaque_tid();
  const int lane = t_ & 63;
  const int gw = (blockIdx.x * blockDim.x + t_) >> 6, nw = (gridDim.x * blockDim.x) >> 6;
  const __amdgpu_buffer_rsrc_t rsx = mk_rsrc(X);
  const __amdgpu_buffer_rsrc_t rso = mk_rsrc(FINAL ? (const void*)O : (const void*)X);
  for (int row = gw; row < MTOK; row += nw) {
    f32x4 v[4];
    float ss = 0.f;
#pragma unroll
    for (int i = 0; i < 4; ++i) {
      v[i] = __builtin_bit_cast(f32x4, ld16(rsx, ((size_t)row * DM + i * 256 + lane * 4) * 4));
      ss += v[i][0] * v[i][0] + v[i][1] * v[i][1] + v[i][2] * v[i][2] + v[i][3] * v[i][3];
    }
#pragma unroll
    for (int o = 32; o >= 1; o >>= 1) ss += __shfl_xor(ss, o);
    const float rstd = rsqrtf(ss * (1.0f / DM) + EPSV);
#pragma unroll
    for (int i = 0; i < 4; ++i) {
      if (FINAL) {
        const f32x4 gg = *(const f32x4*)(g + i * 256 + lane * 4);
        f32x4 o = v[i] * rstd * gg;
        __builtin_amdgcn_raw_buffer_store_b128(__builtin_bit_cast(u32x4, o), rso, (int)(unsigned)(((size_t)row * DM + i * 256 + lane * 4) * 4), 0, 16);
      } else {
        u32x2 o;
        o[0] = pk2(v[i][0] * rstd, v[i][1] * rstd);
        o[1] = pk2(v[i][2] * rstd, v[i][3] * rstd);
        *(u32x2*)(H + (size_t)row * DM + i * 256 + lane * 4) = o;
      }
    }
  }
}

constexpr int LROW = 144;
template <bool SWAP>
DI void gemm_mainloop(const bf16_t* __restrict__ A, const bf16_t* __restrict__ Bm, int m0, int n0, char* lds, f32x16 (&acc)[1][2]) {
  const int tid = opaque_tid(), w = tid >> 6, lane = tid & 63, r = lane & 31, h = lane >> 5;
  const int wm = w & 3, wn = w >> 2;
#pragma unroll
  for (int j = 0; j < 2; ++j)
#pragma unroll
    for (int e = 0; e < 16; ++e) acc[0][j][e] = 0.f;
  u32x4 ra[2], rb[2];
  const __amdgpu_buffer_rsrc_t rsa = mk_rsrc(A), rsb = mk_rsrc(Bm);
  const unsigned oa = (unsigned)(((size_t)(m0 + (tid >> 3)) * 1024 + (tid & 7) * 8) * 2);
  const unsigned ob = (unsigned)(((size_t)(n0 + (tid >> 3)) * 1024 + (tid & 7) * 8) * 2);
#pragma unroll
  for (int i = 0; i < 2; ++i) {
    ra[i] = ld16(rsa, oa + i * 64 * 2048);
    rb[i] = ld16(rsb, ob + i * 64 * 2048);
  }
  const int soff = (tid >> 3) * LROW + (tid & 7) * 16;
  __syncthreads();
#pragma unroll
  for (int i = 0; i < 2; ++i) {
    *(u32x4*)(lds + soff + i * 64 * LROW) = ra[i];
    *(u32x4*)(lds + 128 * LROW + soff + i * 64 * LROW) = rb[i];
  }
#pragma unroll
  for (int i = 0; i < 2; ++i) {
    ra[i] = ld16(rsa, oa + i * 64 * 2048 + 128);
    rb[i] = ld16(rsb, ob + i * 64 * 2048 + 128);
  }
  __syncthreads();
  for (int kt = 0; kt < 16; ++kt) {
    const char* ldsA = lds + (kt & 1) * 256 * LROW;
    const char* ldsB = ldsA + 128 * LROW;
    char* nb = lds + ((kt + 1) & 1) * 256 * LROW;
    const bool st = (kt + 1 < 16), ldn = (kt + 2 < 16);
#pragma unroll
    for (int ks = 0; ks < 4; ++ks) {
      const bf16x8 af = *(const bf16x8*)(ldsA + (32 * wm + r) * LROW + (16 * ks + 8 * h) * 2);
      bf16x8 bfr[2];
#pragma unroll
      for (int j = 0; j < 2; ++j) bfr[j] = *(const bf16x8*)(ldsB + (64 * wn + 32 * j + r) * LROW + (16 * ks + 8 * h) * 2);
#pragma unroll
      for (int j = 0; j < 2; ++j) {
        if (SWAP) acc[0][j] = MFMA(bfr[j], af, acc[0][j]);
        else acc[0][j] = MFMA(af, bfr[j], acc[0][j]);
      }
      const int i = ks >> 1;
      if ((ks & 1) == 0) {
        if (st) *(u32x4*)(nb + soff + i * 64 * LROW) = ra[i];
        if (ldn) ra[i] = ld16(rsa, oa + i * 64 * 2048 + (kt + 2) * 128);
      } else {
        if (st) *(u32x4*)(nb + 128 * LROW + soff + i * 64 * LROW) = rb[i];
        if (ldn) rb[i] = ld16(rsb, ob + i * 64 * 2048 + (kt + 2) * 128);
      }
      __builtin_amdgcn_sched_barrier(0);
    }
    __syncthreads();
  }
}

__device__ void inproj_tile(const Params& p, int l, int tile, char* lds) {
  const int tid = opaque_tid(), w = tid >> 6, lane = tid & 63, r = lane & 31, h = lane >> 5;
  const int wm = w & 3, wn = w >> 2;
  const int nt = tile % 26, mt = tile / 26;
  const int m0 = mt * 128, n0 = nt * 128;
  const bf16_t* Hb = (const bf16_t*)(p.ws + OFF_H);
  const bf16_t* Wt = (const bf16_t*)(p.ws + OFF_WIN) + (size_t)l * DIN * 1024;
  const bool isV = (nt == 3) || (nt == 9) || (nt == 16) || (nt == 17) || (nt == 23);
  const int hc = (n0 >> 6) + wn;
  f32x16 acc[1][2];
  if (isV) {
    gemm_mainloop<false>(Hb, Wt, m0, n0, lds, acc);
    bf16_t* dst; int nh, vh;
    if (hc < 8) { dst = (bf16_t*)(p.ws + OFF_VA); nh = 2; vh = hc - 6; }
    else if (hc < 20) { dst = (bf16_t*)(p.ws + OFF_VB); nh = 2; vh = hc - 18; }
    else if (hc < 36) { dst = (bf16_t*)(p.ws + OFF_VC); nh = 4; vh = hc - 32; }
    else { dst = (bf16_t*)(p.ws + OFF_VD); nh = 2; vh = hc - 46; }
    const int b = m0 >> 13, s0 = (m0 & 8191) + 32 * wm;
    char* slab = lds + w * 5120;
#pragma unroll
    for (int j = 0; j < 2; ++j)
#pragma unroll
      for (int g = 0; g < 4; ++g) {
        u32x2 o;
        o[0] = pk2(acc[0][j][4 * g + 0], acc[0][j][4 * g + 1]);
        o[1] = pk2(acc[0][j][4 * g + 2], acc[0][j][4 * g + 3]);
        *(u32x2*)(slab + (32 * j + r) * 80 + (8 * g + 4 * h) * 2) = o;
      }
    asm volatile("s_waitcnt lgkmcnt(0)" ::: "memory");
    bf16_t* vbase = dst + ((size_t)(b * nh + vh) * 64) * SEQ + s0;
#pragma unroll
    for (int it = 0; it < 4; ++it) {
      const int idx = lane + 64 * it, d = idx >> 2, c = idx & 3;
      const u32x4 vv = *(const u32x4*)(slab + d * 80 + c * 16);
      *(u32x4*)(vbase + (size_t)d * SEQ + c * 8) = vv;
    }
    return;
  }
  gemm_mainloop<true>(Hb, Wt, m0, n0, lds, acc);
  int branch, idx;
  if (hc < 12) { branch = 0; idx = hc; }
  else if (hc < 24) { branch = 1; idx = hc - 12; }
  else if (hc < 40) { branch = 2; idx = hc - 24; }
  else { branch = 3; idx = hc - 40; }
  int kind, head;
  if (branch == 2) {
    if (idx < 4) { kind = 0; head = idx; } else if (idx < 8) { kind = 1; head = idx - 4; } else { kind = 3; head = idx - 12; }
  } else {
    if (idx < 4) { kind = 0; head = idx; } else if (idx < 6) { kind = 1; head = idx - 4; } else { kind = 3; head = idx - 8; }
  }
  constexpr int RROW = 272;
  const bool needs_rope = (kind != 3) && (branch != 2);
  if (needs_rope) {
    const int s0 = m0 & 8191;
    const __amdgpu_buffer_rsrc_t rst = mk_rsrc(p.ws + OFF_T32);
    if (branch == 0) {
      for (int idx = tid; idx < 66 * 16; idx += 512) {
        const int row = idx >> 4, c = idx & 15;
        const int pos = row < 64 ? row : (s0 >> 6) + (row - 64);
        *(u32x4*)(lds + row * RROW + c * 16) = ld16(rst, (size_t)(pos * 16 + c) * 16);
      }
      if (tid < 64) ((float*)(lds + 66 * RROW))[tid] = (kind == 0 ? p.qn_a : p.kn_a)[l * 64 + tid];
    } else {
      for (int idx = tid; idx < 128 * 16; idx += 512) {
        const int row = idx >> 4, c = idx & 15;
        *(u32x4*)(lds + row * RROW + c * 16) = ld16(rst, (size_t)((s0 + row) * 16 + c) * 16);
      }
    }
    __syncthreads();
  }
  const float* gl = (const float*)(lds + 66 * RROW);
#pragma unroll
  for (int i = 0; i < 1; ++i) {
    const int token = m0 + 32 * wm + r;
    const int tl = 32 * wm + r;
    const int b = token >> 13, s = token & 8191;
    f32x16 v0 = acc[i][0], v1 = acc[i][1];
    u32x2 pkd[2][4];
    const int token0 = m0 + 32 * wm;
    bf16_t* rowbase; int rstride;
    if (kind == 3) {
      rowbase = (bf16_t*)(p.ws + OFF_GATE) + (size_t)token0 * 1024 + branch * 256 + head * 64; rstride = 1024;
#pragma unroll
      for (int g = 0; g < 4; ++g) {
        float t[8];
#pragma unroll
        for (int e = 0; e < 4; ++e) {
          const float a0 = v0[4 * g + e], a1 = v1[4 * g + e];
          t[e] = a0 * __builtin_amdgcn_rcpf(1.f + __builtin_amdgcn_exp2f(-a0 * LOG2E));
          t[4 + e] = a1 * __builtin_amdgcn_rcpf(1.f + __builtin_amdgcn_exp2f(-a1 * LOG2E));
        }
        u32x2 o0, o1;
        o0[0] = pk2(t[0], t[1]); o0[1] = pk2(t[2], t[3]);
        o1[0] = pk2(t[4], t[5]); o1[1] = pk2(t[6], t[7]);
        pkd[0][g] = o0; pkd[1][g] = o1;
      }
    } else {
    if (branch == 0) {
      float ss = 0.f;
#pragma unroll
      for (int e = 0; e < 16; ++e) ss += v0[e] * v0[e] + v1[e] * v1[e];
      ss += xor32(ss);
      const float rstd = rsqrtf(ss * (1.f / 64.f) + EPSV);
#pragma unroll
      for (int e = 0; e < 16; ++e) {
        v0[e] = v0[e] * rstd * gl[crow(e, h)];
        v1[e] = v1[e] * rstd * gl[32 + crow(e, h)];
      }
    }
    if (branch == 0 || branch == 3) {
      const int row0 = (branch == 0) ? (64 + (tl >> 6)) : tl;
      const int row1 = (branch == 0) ? (tl & 63) : tl;
#pragma unroll
      for (int e = 0; e < 8; ++e) {
        const int jf = crow(e, h);
        const float2 c0 = *(const float2*)(lds + row0 * RROW + jf * 16);
        const float2 c1 = *(const float2*)(lds + row1 * RROW + jf * 16);
        const float a1 = v0[e], a2 = v0[e + 8];
        v0[e] = a1 * c0.x - a2 * c0.y; v0[e + 8] = a2 * c0.x + a1 * c0.y;
        const float b1 = v1[e], b2 = v1[e + 8];
        v1[e] = b1 * c1.x - b2 * c1.y; v1[e + 8] = b2 * c1.x + b1 * c1.y;
      }
    } else if (branch == 1) {
#pragma unroll
      for (int e = 0; e < 16; ++e) {
        const int jf = crow(e, h);
        const float2 c = *(const float2*)(lds + tl * RROW + jf * 8);
        const float a1 = v0[e], a2 = v1[e];
        v0[e] = a1 * c.x - a2 * c.y; v1[e] = a2 * c.x + a1 * c.y;
      }
    }
    float sc = 1.f;
    if (kind == 0) sc = (branch == 3) ? (0.17677669529663687f * LOG2E) : (0.125f * LOG2E);
    const int b0 = token0 >> 13, s0w = token0 & 8191;
    if (kind == 0) {
      const size_t qoff = (branch == 0) ? OFF_QA : (branch == 1) ? OFF_QB : (branch == 2) ? OFF_QC : OFF_QD;
      rowbase = (bf16_t*)(p.ws + qoff) + ((size_t)(b0 * 4 + head) * SEQ + s0w) * 64;
    } else {
      const size_t koff = (branch == 0) ? OFF_KA : (branch == 1) ? OFF_KB : (branch == 2) ? OFF_KC : OFF_KD;
      const int nh = (branch == 2) ? 4 : 2;
      rowbase = (bf16_t*)(p.ws + koff) + ((size_t)(b0 * nh + head) * SEQ + s0w) * 64;
    }
    rstride = 64;
#pragma unroll
    for (int g = 0; g < 4; ++g) {
      u32x2 o0, o1;
      o0[0] = pk2(v0[4 * g] * sc, v0[4 * g + 1] * sc); o0[1] = pk2(v0[4 * g + 2] * sc, v0[4 * g + 3] * sc);
      o1[0] = pk2(v1[4 * g] * sc, v1[4 * g + 1] * sc); o1[1] = pk2(v1[4 * g + 2] * sc, v1[4 * g + 3] * sc);
      pkd[0][g] = o0; pkd[1][g] = o1;
    }
    }
    char* slab = lds + 36864 + w * 4608;
#pragma unroll
    for (int j = 0; j < 2; ++j)
#pragma unroll
      for (int g = 0; g < 4; ++g) *(u32x2*)(slab + r * 144 + (32 * j + 8 * g + 4 * h) * 2) = pkd[j][g];
    asm volatile("s_waitcnt lgkmcnt(0)" ::: "memory");
#pragma unroll
    for (int it = 0; it < 4; ++it) {
      const int row = (lane >> 3) + 8 * it, c = lane & 7;
      const u32x4 vv = *(const u32x4*)(slab + row * 144 + c * 16);
      *(u32x4*)(rowbase + (size_t)row * rstride + c * 8) = vv;
    }
  }
}

__device__ void outproj_tile(const Params& p, int l, int tile, char* lds, const float* __restrict__ xin, float* __restrict__ xout) {
  const int tid = opaque_tid(), w = tid >> 6, lane = tid & 63, r = lane & 31, h = lane >> 5;
  const int wm = w & 3, wn = w >> 2;
  const int nt = tile & 7, mt = tile >> 3;
  const int m0 = mt * 128, n0 = nt * 128;
  const bf16_t* Mx = (const bf16_t*)(p.ws + OFF_MIX);
  const bf16_t* Wt = (const bf16_t*)(p.ws + OFF_WOUT) + (size_t)l * 1024 * 1024;
  f32x16 acc[1][2];
  const __amdgpu_buffer_rsrc_t rsxin = mk_rsrc(xin);
  gemm_mainloop<false>(Mx, Wt, m0, n0, lds, acc);
#pragma unroll
  for (int i = 0; i < 1; ++i)
#pragma unroll
    for (int j = 0; j < 2; ++j) {
      const int n = n0 + 64 * wn + 32 * j + r;
#pragma unroll
      for (int e = 0; e < 16; ++e) {
        const int m = m0 + 32 * wm + crow(e, h);
        const size_t o = (size_t)m * DM + n;
        xout[o] = __uint_as_float(ld4(rsxin, o * 4)) + acc[i][j][e];
      }
    }
}

enum { MA = 0, MB = 1, MC = 2, MD = 3 };

template <int MODE>
__device__ void attn_item(const Params& p, int l, int item, char* lds) {
  const int tid = opaque_tid(), w = tid >> 6, lane = tid & 63, r = lane & 31, h = lane >> 5;
  const int qg = w & 3, role = w >> 2;
  constexpr int NKS = (MODE == MD) ? 2 : 4;
  constexpr bool FAST = (MODE == MA || MODE == MD);
  constexpr bool NEGM = FAST;
  constexpr float P_THR = 256.f;
  float* ldsR = (float*)(lds + 256 * LROW);

  int b, qtok, ktlo, kthi, head_out, koff = 0;
  const bf16_t *Qp, *Kg, *Vg;
  int qrow = 0, rs = 0, qcol0 = 0;
  if (MODE == MA || MODE == MB) {
    b = item >> 7; const int kvh = (item >> 6) & 1, qb = item & 63;
    qtok = qb * 128 + 32 * qg + r;
    head_out = kvh * 2 + role;
    Qp = (const bf16_t*)(p.ws + (MODE == MA ? OFF_QA : OFF_QB)) + ((size_t)(b * 4 + head_out) * SEQ + qtok) * 64 + 8 * h;
    const int kvrow = b * 2 + kvh;
    Kg = (const bf16_t*)(p.ws + (MODE == MA ? OFF_KA : OFF_KB)) + (size_t)kvrow * SEQ * 64;
    Vg = (const bf16_t*)(p.ws + (MODE == MA ? OFF_VA : OFF_VB)) + (size_t)kvrow * 64 * SEQ;
    if (MODE == MA) { ktlo = 0; kthi = 128; }
    else { ktlo = max(0, qb * 2 - 2); kthi = min(128, qb * 2 + 4); }
  } else if (MODE == MD) {
    b = item >> 8; const int hq = (item >> 6) & 3, qb = item & 63;
    qtok = qb * 128 + 32 * qg + r;
    head_out = hq;
    koff = 32 * role;
    Qp = (const bf16_t*)(p.ws + OFF_QD) + ((size_t)(b * 4 + hq) * SEQ + qtok) * 64 + koff + 8 * h;
    const int kvrow = b * 2 + (hq >> 1);
    Kg = (const bf16_t*)(p.ws + OFF_KD) + (size_t)kvrow * SEQ * 64;
    Vg = (const bf16_t*)(p.ws + OFF_VD) + (size_t)kvrow * 64 * SEQ;
    ktlo = 0; kthi = 128;
  } else {
    b = item >> 7; const int hh = (item >> 5) & 3, rg = item & 31;
    qrow = rg * 4 + qg;
    rs = min(max(qrow - 4, 0), 120);
    qcol0 = 32 * role;
    qtok = qrow * 64 + qcol0 + r;
    head_out = hh;
    Qp = (const bf16_t*)(p.ws + OFF_QC) + ((size_t)(b * 4 + hh) * SEQ + qtok) * 64 + 8 * h;
    const int kvrow = b * 4 + hh;
    Kg = (const bf16_t*)(p.ws + OFF_KC) + (size_t)kvrow * SEQ * 64;
    Vg = (const bf16_t*)(p.ws + OFF_VC) + (size_t)kvrow * 64 * SEQ;
    ktlo = min(max(rg * 4 - 4, 0), 120);
    kthi = min(max(rg * 4 + 3 - 4, 0), 120) + 8;
    const float* rp = p.rpb_c + ((size_t)l * 4 + hh) * 465;
    for (int i = tid; i < 465; i += 512) ldsR[i] = rp[i] * LOG2E;
  }

  const __amdgpu_buffer_rsrc_t rsw = mk_rsrc(p.ws);
  bf16x8 qf[NKS];
#pragma unroll
  for (int ks = 0; ks < NKS; ++ks) qf[ks] = __builtin_bit_cast(bf16x8, ld16(rsw, (size_t)((const char*)(Qp + 16 * ks) - p.ws)));

  f32x16 O[2];
#pragma unroll
  for (int db = 0; db < 2; ++db)
#pragma unroll
    for (int e = 0; e < 16; ++e) O[db][e] = 0.f;
  float mrun, lrun;
  if (MODE == MB) { mrun = p.sink_b[l * 4 + head_out] * LOG2E; lrun = 0.5f; }
  else { mrun = NEG; lrun = 0.f; }
  f32x16 negm;
  if (FAST) {
    f32x16 s0;
#pragma unroll
    for (int e = 0; e < 16; ++e) s0[e] = 0.f;
#pragma unroll
    for (int ks = 0; ks < NKS; ++ks) {
      const bf16_t* kp = Kg + ((size_t)ktlo * 64 + r) * 64 + koff + 16 * ks + 8 * h;
      const bf16x8 k0 = __builtin_bit_cast(bf16x8, ld16(rsw, (size_t)((const char*)kp - p.ws)));
      s0 = MFMA(k0, qf[ks], s0);
    }
    float m0 = s0[0];
#pragma unroll
    for (int e = 1; e < 16; ++e) m0 = fmaxf(m0, s0[e]);
    m0 = fmaxf(m0, xor32(m0));
    mrun = m0;
#pragma unroll
    for (int e = 0; e < 16; ++e) negm[e] = -m0;
  }
  u32x4 kreg, vreg;
  const int lrow = tid >> 3, lch = tid & 7;
  const bf16_t* kgp = Kg + (size_t)lrow * 64 + lch * 8;
  const bf16_t* vgp = Vg + (size_t)lrow * SEQ + lch * 8;
  kreg = ld16(rsw, (size_t)((const char*)(kgp + (size_t)ktlo * 64 * 64) - p.ws));
  vreg = ld16(rsw, (size_t)((const char*)(vgp + ktlo * 64) - p.ws));
  const int soff = lrow * LROW + lch * 16;
  const int vsoff = lrow * LROW + (lch >> 1) * 32 + (lch & 1) * 8;

  __syncthreads();
  *(u32x4*)(lds + soff) = kreg;
  { u32x2 lo_ = {vreg[0], vreg[1]}, hi_ = {vreg[2], vreg[3]}; *(u32x2*)(lds + 64 * LROW + vsoff) = lo_; *(u32x2*)(lds + 64 * LROW + vsoff + 16) = hi_; }
  if (ktlo + 1 < kthi) {
    kreg = ld16(rsw, (size_t)((const char*)(kgp + (size_t)(ktlo + 1) * 64 * 64) - p.ws));
    vreg = ld16(rsw, (size_t)((const char*)(vgp + (ktlo + 1) * 64) - p.ws));
  }
  __syncthreads();
  for (int kt = ktlo; kt < kthi; ++kt) {
    const int cur = (kt - ktlo) & 1;
    const char* ldsK = lds + cur * 128 * LROW;
    const char* ldsV = ldsK + 64 * LROW;
    if (kt + 1 < kthi) {
      char* nb = lds + (cur ^ 1) * 128 * LROW;
      *(u32x4*)(nb + soff) = kreg;
      { u32x2 lo_ = {vreg[0], vreg[1]}, hi_ = {vreg[2], vreg[3]}; *(u32x2*)(nb + 64 * LROW + vsoff) = lo_; *(u32x2*)(nb + 64 * LROW + vsoff + 16) = hi_; }
    }
    if (kt + 2 < kthi) {
      kreg = ld16(rsw, (size_t)((const char*)(kgp + (size_t)(kt + 2) * 64 * 64) - p.ws));
      vreg = ld16(rsw, (size_t)((const char*)(vgp + (kt + 2) * 64) - p.ws));
    }
    bool active = true;
    if (MODE == MC) active = (kt >= rs) && (kt < rs + 8);
    if (active) {
#pragma nounroll
      for (int kb = 0; kb < 2; ++kb) {
        bf16x8 pf[2];
        if (FAST) {
          f32x16 S = negm;
#pragma unroll
          for (int ks = 0; ks < NKS; ++ks) {
            const bf16x8 k0 = *(const bf16x8*)(ldsK + (32 * kb + r) * LROW + (koff + 16 * ks + 8 * h) * 2);
            S = MFMA(k0, qf[ks], S);
          }
          float ls = 0.f;
#pragma unroll
          for (int e = 0; e < 16; ++e) { S[e] = __builtin_amdgcn_exp2f(S[e]); ls += S[e]; }
          if (__any(!(ls <= P_THR))) {
            S = negm;
#pragma unroll
            for (int ks = 0; ks < NKS; ++ks) {
              const bf16x8 k0 = *(const bf16x8*)(ldsK + (32 * kb + r) * LROW + (koff + 16 * ks + 8 * h) * 2);
              S = MFMA(k0, qf[ks], S);
            }
            float mx = S[0];
#pragma unroll
            for (int e = 1; e < 16; ++e) mx = fmaxf(mx, S[e]);
            mx = fmaxf(mx, xor32(mx));
            const float d = fmaxf(mx, 0.f);
            const float alpha = __builtin_amdgcn_exp2f(-d);
            mrun += d;
            lrun *= alpha;
#pragma unroll
            for (int db = 0; db < 2; ++db)
#pragma unroll
              for (int e = 0; e < 16; ++e) O[db][e] *= alpha;
#pragma unroll
            for (int e = 0; e < 16; ++e) negm[e] -= d;
            ls = 0.f;
#pragma unroll
            for (int e = 0; e < 16; ++e) { S[e] = __builtin_amdgcn_exp2f(S[e] - d); ls += S[e]; }
          }
#pragma unroll
          for (int s = 0; s < 2; ++s) {
            u32x4 pk;
            pk[0] = pk2(S[8 * s + 0], S[8 * s + 1]); pk[1] = pk2(S[8 * s + 2], S[8 * s + 3]);
            pk[2] = pk2(S[8 * s + 4], S[8 * s + 5]); pk[3] = pk2(S[8 * s + 6], S[8 * s + 7]);
            pf[s] = __builtin_bit_cast(bf16x8, pk);
          }
          lrun += ls;
        } else {
          f32x16 S;
#pragma unroll
          for (int e = 0; e < 16; ++e) S[e] = 0.f;
#pragma unroll
          for (int ks = 0; ks < NKS; ++ks) {
            const bf16x8 k0 = *(const bf16x8*)(ldsK + (32 * kb + r) * LROW + (16 * ks + 8 * h) * 2);
            S = MFMA(k0, qf[ks], S);
          }
          if (MODE == MB) {
#pragma unroll
            for (int e = 0; e < 16; ++e) {
              const int kpos = kt * 64 + 32 * kb + crow(e, h);
              const int dlt = qtok - kpos;
              const bool ok = (dlt <= 128) && (dlt >= -128);
              S[e] = ok ? S[e] : NEG;
            }
          }
          if (MODE == MC) {
            const int dr = kt - qrow + 7;
            const int qcol = qcol0 + r;
            const int cs = min(max(qcol - 8, 0), 48);
#pragma unroll
            for (int e = 0; e < 16; ++e) {
              const int kcol = 32 * kb + crow(e, h);
              const bool ok = (kcol >= cs) && (kcol < cs + 16);
              const int dc = min(max(kcol - qcol, -15), 15) + 15;
              const float bias = ldsR[dr * 31 + dc];
              S[e] = ok ? (S[e] + bias) : NEG;
            }
          }
          float mx = S[0];
#pragma unroll
          for (int e = 1; e < 16; ++e) mx = fmaxf(mx, S[e]);
          mx = fmaxf(mx, xor32(mx));
          if (__any(mx > mrun)) {
            const float mn = fmaxf(mrun, mx);
            const float alpha = __builtin_amdgcn_exp2f(mrun - mn);
            mrun = mn;
            lrun *= alpha;
#pragma unroll
            for (int db = 0; db < 2; ++db)
#pragma unroll
              for (int e = 0; e < 16; ++e) O[db][e] *= alpha;
          }
          const float mn = mrun;
          float ls = 0.f;
#pragma unroll
          for (int e = 0; e < 16; ++e) {
            const float pvv = __builtin_amdgcn_exp2f(S[e] - mn);
            S[e] = pvv;
            ls += pvv;
          }
          lrun += ls;
#pragma unroll
          for (int s = 0; s < 2; ++s) {
            u32x4 pk;
            pk[0] = pk2(S[8 * s + 0], S[8 * s + 1]); pk[1] = pk2(S[8 * s + 2], S[8 * s + 3]);
            pk[2] = pk2(S[8 * s + 4], S[8 * s + 5]); pk[3] = pk2(S[8 * s + 6], S[8 * s + 7]);
            pf[s] = __builtin_bit_cast(bf16x8, pk);
          }
        }
#pragma unroll
        for (int s = 0; s < 2; ++s)
#pragma unroll
          for (int db = 0; db < 2; ++db) {
            const bf16x8 vf = *(const bf16x8*)(ldsV + (32 * db + r) * LROW + (32 * kb + 16 * s) * 2 + 16 * h);
            O[db] = MFMA(vf, pf[s], O[db]);
          }
      }
    }
    __syncthreads();
  }

  bf16_t* mix = (bf16_t*)(p.ws + OFF_MIX);
  lrun += xor32(lrun);
  const float inv = 1.f / lrun;
  if (MODE == MD) {
    float* xch = (float*)lds + (size_t)qg * 32 * 64 + lane;
    __syncthreads();
    if (role == 1) {
#pragma unroll
      for (int db = 0; db < 2; ++db)
#pragma unroll
        for (int e = 0; e < 16; ++e) xch[(db * 16 + e) * 64] = O[db][e] * inv;
    }
    __syncthreads();
    if (role == 1) return;
    const float lam = __uint_as_float(ld4(rsw, OFF_CTRL + (16 + l * 2 + 0) * 4)), omli = __uint_as_float(ld4(rsw, OFF_CTRL + (16 + l * 2 + 1) * 4));
    f32x16 o[2];
    float ss = 0.f;
#pragma unroll
    for (int db = 0; db < 2; ++db)
#pragma unroll
      for (int e = 0; e < 16; ++e) {
        const float t = O[db][e] * inv - lam * xch[(db * 16 + e) * 64];
        o[db][e] = t;
        ss += t * t;
      }
    ss += xor32(ss);
    const float rstd = rsqrtf(ss * (1.f / 64.f) + EPSV) * omli;
    const size_t base = (size_t)(b * SEQ + qtok) * 1024 + 768 + head_out * 64 + 4 * h;
    const float* sg = p.subln + l * 64 + 4 * h;
#pragma unroll
    for (int db = 0; db < 2; ++db)
#pragma unroll
      for (int g = 0; g < 4; ++g) {
        const size_t off = base + 32 * db + 8 * g;
        const u32x2 gv = ld8(rsw, OFF_GATE + off * 2);
        const float g0 = __uint_as_float(gv[0] << 16), g1 = __uint_as_float(gv[0] & 0xffff0000u);
        const float g2 = __uint_as_float(gv[1] << 16), g3 = __uint_as_float(gv[1] & 0xffff0000u);
        const float* sgp = sg + 32 * db + 8 * g;
        u32x2 ov;
        ov[0] = pk2(o[db][4 * g + 0] * rstd * sgp[0] * g0, o[db][4 * g + 1] * rstd * sgp[1] * g1);
        ov[1] = pk2(o[db][4 * g + 2] * rstd * sgp[2] * g2, o[db][4 * g + 3] * rstd * sgp[3] * g3);
        *(u32x2*)(mix + off) = ov;
      }
  } else {
    const int brc = (MODE == MA) ? 0 : (MODE == MB) ? 256 : 512;
    const size_t base = (size_t)(b * SEQ + qtok) * 1024 + brc + head_out * 64 + 4 * h;
#pragma unroll
    for (int db = 0; db < 2; ++db)
#pragma unroll
      for (int g = 0; g < 4; ++g) {
        const size_t off = base + 32 * db + 8 * g;
        const u32x2 gv = ld8(rsw, OFF_GATE + off * 2);
        const float g0 = __uint_as_float(gv[0] << 16), g1 = __uint_as_float(gv[0] & 0xffff0000u);
        const float g2 = __uint_as_float(gv[1] << 16), g3 = __uint_as_float(gv[1] & 0xffff0000u);
        u32x2 ov;
        ov[0] = pk2(O[db][4 * g + 0] * inv * g0, O[db][4 * g + 1] * inv * g1);
        ov[1] = pk2(O[db][4 * g + 2] * inv * g2, O[db][4 * g + 3] * inv * g3);
        *(u32x2*)(mix + off) = ov;
      }
  }
}

constexpr int N_D = 512, N_A = 256, N_B = 256, N_C = 256;
constexpr int N_ATT = N_D + N_A + N_B + N_C;

__device__ void phase_prep(const Params& p, char* lds) {
  const int tid = opaque_tid();
  const int gtid = blockIdx.x * blockDim.x + tid, nth = gridDim.x * blockDim.x;
  if (blockIdx.x == 0 && tid == 0) {
    float* cf = (float*)(p.ws + OFF_CTRL) + 16;
    for (int l = 0; l < 2; ++l) {
      float s1 = 0.f, s2 = 0.f;
      for (int i = 0; i < 32; ++i) { s1 += p.lq1[l * 32 + i] * p.lk1[l * 32 + i]; s2 += p.lq2[l * 32 + i] * p.lk2[l * 32 + i]; }
      const float li = (l == 0) ? 0.2f : 0.35550906759096934f;
      cf[l * 2 + 0] = __expf(s1) - __expf(s2) + li;
      cf[l * 2 + 1] = 1.0f - li;
    }
  }
  float2* T32 = (float2*)(p.ws + OFF_T32);
  for (int i = gtid; i < SEQ * 32; i += nth) {
    const int pos = i >> 5, j = i & 31;
    const float ang = (float)pos * INV32[j];
    float sn, cs;
    sincos_d(ang, sn, cs);
    T32[i] = make_float2(cs, sn);
  }
  const int half = tid >> 8, tl = tid & 255;
  for (int tp = blockIdx.x; tp < 832 + 256; tp += gridDim.x) {
    const int t = 2 * tp + half;
    const int l = t / 1088, tt = t % 1088;
    float* lf = (float*)(lds + half * 20480);
    if (tt < 832) wconv_tile(p.w_in + (size_t)l * 1024 * DIN, p.norm_g + l * 1024, (bf16_t*)(p.ws + OFF_WIN) + (size_t)l * DIN * 1024, DIN, tt, lf, tl);
    else wconv_tile(p.w_out + (size_t)l * 1024 * 1024, nullptr, (bf16_t*)(p.ws + OFF_WOUT) + (size_t)l * 1024 * 1024, 1024, tt - 832, lf, tl);
  }
  rms_rows<false>(p.x, (bf16_t*)(p.ws + OFF_H), nullptr, nullptr);
}

__device__ void phase_inproj(const Params& p, int l, char* lds) {
  if ((gridDim.x & 7) == 0) {
    const int xcd = blockIdx.x & 7, slot = blockIdx.x >> 3, slots = gridDim.x >> 3;
    for (int q = slot; q < 16 * 26; q += slots) {
      int mtl, nt;
      if (q < 384) { const int ng = q >> 7, rem = q & 127, w8 = rem & 63; mtl = (rem >> 6) * 8 + (w8 & 7); nt = ng * 8 + (w8 >> 3); }
      else { const int rem = q - 384; mtl = rem & 15; nt = 24 + (rem >> 4); }
      inproj_tile(p, l, (xcd * 16 + mtl) * 26 + nt, lds);
    }
  } else {
    for (int t = blockIdx.x; t < 128 * 26; t += gridDim.x) inproj_tile(p, l, t, lds);
  }
}

DI int fetch_item(unsigned* ctr, int* s_item) {
  __syncthreads();
  if (threadIdx.x == 0) *s_item = (int)atomicAdd(ctr, 1u);
  __syncthreads();
  return *s_item;
}

__device__ void phase_attn(const Params& p, int l, char* lds, int* s_item, int cidx) {
  unsigned* ctr = (unsigned*)(p.ws + OFF_CTRL) + cidx;
  int item = blockIdx.x;
  while (item < N_A) { attn_item<MA>(p, l, item, lds); item = (int)gridDim.x + fetch_item(ctr, s_item); }
  while (item < N_A + N_D) { attn_item<MD>(p, l, item - N_A, lds); item = (int)gridDim.x + fetch_item(ctr, s_item); }
  while (item < N_A + N_D + N_B) { attn_item<MB>(p, l, item - N_A - N_D, lds); item = (int)gridDim.x + fetch_item(ctr, s_item); }
  while (item < N_ATT) { attn_item<MC>(p, l, item - N_A - N_D - N_B, lds); item = (int)gridDim.x + fetch_item(ctr, s_item); }
}

__device__ void phase_outproj(const Params& p, int l, char* lds) {
  const float* xin = (l == 0) ? p.x : (const float*)(p.ws + OFF_X1);
  float* xout = (l == 0) ? (float*)(p.ws + OFF_X1) : p.out;
  if ((gridDim.x & 7) == 0) {
    const int xcd = blockIdx.x & 7, slot = blockIdx.x >> 3, slots = gridDim.x >> 3;
    for (int q = slot; q < 16 * 8; q += slots) {
      const int w8 = q & 63, mtl = (q >> 6) * 8 + (w8 & 7), nt = w8 >> 3;
      outproj_tile(p, l, (xcd * 16 + mtl) * 8 + nt, lds, xin, xout);
    }
  } else {
    for (int t = blockIdx.x; t < 128 * 8; t += gridDim.x) outproj_tile(p, l, t, lds, xin, xout);
  }
}

__global__ void __launch_bounds__(512, 4) fwd_megakernel(Params p) {
  __shared__ __attribute__((aligned(16))) char lds[4 * 128 * LROW];
  __shared__ int s_item;
  __shared__ uint4 xb_words;
  if (p.ws == nullptr) cg::this_grid().sync();
  if (threadIdx.x == 0) xb_words = make_uint4(0u, 0u, 0u, 0u);
  __syncthreads();
  XcdBarrier gb = xcd_barrier_post((unsigned*)(p.ws + OFF_BAR), (volatile LAS unsigned*)&xb_words);
  phase_prep(p, lds);
  xcd_barrier(gb);
  for (int l = 0; l < 2; ++l) {
    phase_inproj(p, l, lds);
    xcd_barrier(gb);
    phase_attn(p, l, lds, &s_item, l);
    xcd_barrier(gb);
#ifdef PROBE_ATTN2
    phase_attn(p, l, lds, &s_item, l + 2);
    xcd_barrier(gb);
#endif
#ifdef PROBE_GEMM2
    phase_inproj(p, l, lds);
    xcd_barrier(gb);
#endif
    phase_outproj(p, l, lds);
    xcd_barrier(gb);
    if (l == 0) {
      rms_rows<false>((const float*)(p.ws + OFF_X1), (bf16_t*)(p.ws + OFF_H), nullptr, nullptr);
      xcd_barrier(gb);
    } else {
      rms_rows<true>(p.out, nullptr, p.out, p.final_g);
    }
  }
}

extern "C" void kernel_launch(void* const* d_in, const int* in_sizes, int n_in, void* d_out,
                              int out_size, void* d_ws, size_t ws_size, hipStream_t stream) {
  static int grid_blocks = 0;
  if (!grid_blocks) {
    int dev = 0, cus = 0, per_cu = 0;
    (void)hipGetDevice(&dev);
    (void)hipDeviceGetAttribute(&cus, hipDeviceAttributeMultiprocessorCount, dev);
    (void)hipOccupancyMaxActiveBlocksPerMultiprocessor(&per_cu, fwd_megakernel, 512, 0);
    if (per_cu > 2) per_cu = 2;
    if (per_cu < 1) per_cu = 1;
    grid_blocks = cus * per_cu;
  }
  if (ws_size < WS_NEEDED) { fprintf(stderr, "workspace too small\n"); return; }
  Params p{};
  p.x = (const float*)d_in[0]; p.norm_g = (const float*)d_in[1]; p.w_in = (const float*)d_in[2]; p.w_out = (const float*)d_in[3];
  p.qn_a = (const float*)d_in[4]; p.kn_a = (const float*)d_in[5]; p.sink_b = (const float*)d_in[6]; p.rpb_c = (const float*)d_in[7];
  p.lq1 = (const float*)d_in[8]; p.lk1 = (const float*)d_in[9]; p.lq2 = (const float*)d_in[10]; p.lk2 = (const float*)d_in[11];
  p.subln = (const float*)d_in[12]; p.final_g = (const float*)d_in[13];
  p.out = (float*)d_out; p.ws = (char*)d_ws;
  (void)hipMemsetAsync(d_ws, 0, OFF_T32, stream);
  void* args[] = {&p};
  hipError_t e = hipLaunchCooperativeKernel((void*)fwd_megakernel, dim3(grid_blocks), dim3(512), args, 0, stream);
  if (e != hipSuccess) fprintf(stderr, "cooperative launch failed: %s (grid %d)\n", hipGetErrorString(e), grid_blocks);
}
```

```cpp
#include <hip/hip_runtime.h>
#include <hip/hip_cooperative_groups.h>
#include <cstdio>
#include <cstdint>
namespace cg = cooperative_groups;

#define DI __device__ __forceinline__
typedef unsigned short bf16_t;
typedef short bf16x8 __attribute__((ext_vector_type(8)));
typedef short s16x4 __attribute__((ext_vector_type(4)));
typedef float f32x16 __attribute__((ext_vector_type(16)));
typedef float f32x4 __attribute__((ext_vector_type(4)));
typedef float f32x2 __attribute__((ext_vector_type(2)));
typedef __bf16 bf16x2_t __attribute__((ext_vector_type(2)));
typedef unsigned u32x2 __attribute__((ext_vector_type(2)));
typedef unsigned u32x4 __attribute__((ext_vector_type(4)));

#define MFMA(a, b, c) __builtin_amdgcn_mfma_f32_32x32x16_bf16((a), (b), (c), 0, 0, 0)

constexpr int SEQ = 8192, DM = 1024, DIN = 3328, MTOK = 16384;
constexpr float LOG2E = 1.4426950408889634f;
constexpr float EPSV = 1e-6f;
constexpr float NEG = -1e30f;

constexpr size_t MiB = 1024 * 1024;
constexpr size_t OFF_BAR = 0;
constexpr size_t OFF_CTRL = 16384;
constexpr size_t OFF_T32 = 20480;
constexpr size_t OFF_WIN = OFF_T32 + 2 * MiB;
constexpr size_t OFF_WOUT = OFF_WIN + 13 * MiB;
constexpr size_t OFF_H = OFF_WOUT + 4 * MiB;
constexpr size_t OFF_QA = OFF_H + 32 * MiB;
constexpr size_t OFF_KA = OFF_QA + 8 * MiB;
constexpr size_t OFF_VA = OFF_KA + 4 * MiB;
constexpr size_t OFF_QB = OFF_VA + 4 * MiB;
constexpr size_t OFF_KB = OFF_QB + 8 * MiB;
constexpr size_t OFF_VB = OFF_KB + 4 * MiB;
constexpr size_t OFF_QC = OFF_VB + 4 * MiB;
constexpr size_t OFF_KC = OFF_QC + 8 * MiB;
constexpr size_t OFF_VC = OFF_KC + 8 * MiB;
constexpr size_t OFF_QD = OFF_VC + 8 * MiB;
constexpr size_t OFF_KD = OFF_QD + 8 * MiB;
constexpr size_t OFF_VD = OFF_KD + 4 * MiB;
constexpr size_t OFF_GATE = OFF_VD + 4 * MiB;
constexpr size_t OFF_X1 = OFF_GATE + 32 * MiB;
constexpr size_t OFF_MIX = OFF_X1 + 64 * MiB;
constexpr size_t WS_NEEDED = OFF_MIX + 32 * MiB;

struct Params {
  const float *x, *norm_g, *w_in, *w_out, *qn_a, *kn_a, *sink_b, *rpb_c, *lq1, *lk1, *lq2, *lk2, *subln, *final_g;
  float* out;
  char* ws;
};

__device__ const float INV32[32] = {
    1.000000000e+00f, 7.498942614e-01f, 5.623413324e-01f, 4.216965139e-01f, 3.162277639e-01f, 2.371373773e-01f,
    1.778279394e-01f, 1.333521307e-01f, 1.000000015e-01f, 7.498941571e-02f, 5.623413250e-02f, 4.216965288e-02f,
    3.162277490e-02f, 2.371373773e-02f, 1.778279431e-02f, 1.333521493e-02f, 9.999999776e-03f, 7.498941850e-03f,
    5.623413250e-03f, 4.216964822e-03f, 3.162277630e-03f, 2.371373586e-03f, 1.778279431e-03f, 1.333521446e-03f,
    1.000000047e-03f, 7.498942432e-04f, 5.623413017e-04f, 4.216965172e-04f, 3.162277571e-04f, 2.371373703e-04f,
    1.778279402e-04f, 1.333521504e-04f};

DI unsigned pk2(float a, float b) {
  f32x2 v = {a, b};
  return __builtin_bit_cast(unsigned, __builtin_convertvector(v, bf16x2_t));
}
DI float bf2f(unsigned short u) { return __uint_as_float(((unsigned)u) << 16); }
DI int crow(int reg, int h) { return (reg & 3) + 8 * (reg >> 2) + 4 * h; }
DI float xor32(float v) { return __shfl_xor(v, 32); }
DI __amdgpu_buffer_rsrc_t mk_rsrc(const void* base) { return __builtin_amdgcn_make_buffer_rsrc((void*)base, 0, 0x7fffffff, 0x00020000); }
DI u32x4 ld16(__amdgpu_buffer_rsrc_t rs, size_t byte_off) { return __builtin_amdgcn_raw_buffer_load_b128(rs, (int)(unsigned)byte_off, 0, 16); }
DI u32x2 ld8(__amdgpu_buffer_rsrc_t rs, size_t byte_off) { return __builtin_amdgcn_raw_buffer_load_b64(rs, (int)(unsigned)byte_off, 0, 16); }
DI unsigned ld4(__amdgpu_buffer_rsrc_t rs, size_t byte_off) { return __builtin_amdgcn_raw_buffer_load_b32(rs, (int)(unsigned)byte_off, 0, 16); }
DI int opaque_tid() { int t = threadIdx.x; asm volatile("" : "+v"(t)); return t; }


#define XB_TMO      128
#define XB_XCNT(j)  (256  + 64 * (j))
#define XB_XSUB(j)  (1280 + 64 * (j))
#define XB_XGEN(j)  (2304 + 64 * (j))
#define XB_TOP      3328
#define XB_TOPGEN   3392
#define XCD_BAR_WORDS 3456
#define XB_SPIN_CAP (1u << 20)
#define LAS __attribute__((address_space(3)))
DI unsigned xb_ld(unsigned* p) { return __hip_atomic_load(p, __ATOMIC_RELAXED, __HIP_MEMORY_SCOPE_AGENT); }
DI unsigned xb_add(unsigned* p, unsigned v) { return __hip_atomic_fetch_add(p, v, __ATOMIC_RELAXED, __HIP_MEMORY_SCOPE_AGENT); }
DI unsigned xb_xcc_id() { return (unsigned)__builtin_amdgcn_s_getreg((3 << 11) | 20) & 0xFu; }
#define XB_SPIN(cond, bar) do { unsigned _sp = 0; while (cond) { __builtin_amdgcn_s_sleep(1); \
    if ((++_sp & 255u) == 0u) { if (xb_ld(&(bar)[XB_TMO])) break; if (_sp > XB_SPIN_CAP) { atomicAdd(&(bar)[XB_TMO], 1u); break; } } } } while (0)
struct XcdBarrier { unsigned* bar; unsigned x; volatile LAS unsigned* st; };
DI XcdBarrier xcd_barrier_post(unsigned* bar, volatile LAS unsigned* st) {
  XcdBarrier b; b.bar = bar; b.x = xb_xcc_id(); b.st = st;
  if (threadIdx.x == 0) (void)xb_add(&bar[XB_XCNT(b.x)], 1u);
  return b;
}
DI void xcd_barrier_complete(unsigned* bar, unsigned x, unsigned& nloc, unsigned& nx) {
  const unsigned G = gridDim.x * gridDim.y * gridDim.z;
  unsigned sum, cnt, mine, sp = 0u;
  for (;;) {
    sum = 0u; cnt = 0u; mine = 0u;
#pragma unroll
    for (unsigned j = 0; j < 16; ++j) { const unsigned c = xb_ld(&bar[XB_XCNT(j)]); sum += c; cnt += (c > 0u) ? 1u : 0u; mine = (j == x) ? c : mine; }
    if (sum == G) break;
    __builtin_amdgcn_s_sleep(1);
    if ((++sp & 255u) == 0u) { if (xb_ld(&bar[XB_TMO])) break; if (sp > XB_SPIN_CAP) { atomicAdd(&bar[XB_TMO], 1u); break; } }
  }
  nloc = mine > 0u ? mine : 1u; nx = cnt > 0u ? cnt : 1u;
}
DI void xcd_barrier(const XcdBarrier& b) {
  asm volatile("s_waitcnt vmcnt(0)" ::: "memory");
  __syncthreads();
  if (threadIdx.x == 0) {
    unsigned* bar = b.bar;
    asm volatile("" : "+s"(bar));
    __builtin_amdgcn_s_waitcnt(0);
    unsigned nloc = b.st[0], nx = b.st[1];
    if (nloc == 0u) { xcd_barrier_complete(bar, b.x, nloc, nx); b.st[0] = nloc; b.st[1] = nx; }
    unsigned bx = b.x;
    asm volatile("" : "+s"(bx));
    const unsigned old = xb_add(&bar[XB_XSUB(bx)], 1u);
    const unsigned gen = old / nloc;
    if (old + 1u == (gen + 1u) * nloc) {
      __builtin_amdgcn_fence(__ATOMIC_RELEASE, "agent");
      asm volatile("s_waitcnt vmcnt(0)" ::: "memory");
      const unsigned og = xb_add(&bar[XB_TOP], 1u);
      const unsigned tg = og / nx;
      if (og + 1u == (tg + 1u) * nx) xb_add(&bar[XB_TOPGEN], 1u);
      else XB_SPIN(xb_ld(&bar[XB_TOPGEN]) == tg, bar);
      __builtin_amdgcn_fence(__ATOMIC_ACQUIRE, "agent");
      xb_add(&bar[XB_XGEN(bx)], 1u);
      asm volatile("s_waitcnt vmcnt(0)" ::: "memory");
    } else {
      XB_SPIN(xb_ld(&bar[XB_XGEN(bx)]) == gen, bar);
      __builtin_amdgcn_fence(__ATOMIC_ACQUIRE, "agent");
      asm volatile("s_waitcnt vmcnt(0)" ::: "memory");
    }
  }
  __syncthreads();
}

DI void sincos_d(float angf, float& sn, float& cs) {
  const double a = (double)angf;
  const double q = __builtin_rint(a * 0.63661977236758134308);
  double r = __builtin_fma(-q, 1.57079632679489655800e+00, a);
  r = __builtin_fma(-q, 6.12323399573676603587e-17, r);
  const int n = ((int)q) & 3;
  const double r2 = r * r;
  double sp = 1.0 / 6227020800.0;
  sp = sp * r2 - 1.0 / 39916800.0;
  sp = sp * r2 + 1.0 / 362880.0;
  sp = sp * r2 - 1.0 / 5040.0;
  sp = sp * r2 + 1.0 / 120.0;
  sp = sp * r2 - 1.0 / 6.0;
  sp = r + r * r2 * sp;
  double cp = -1.0 / 87178291200.0;
  cp = cp * r2 + 1.0 / 479001600.0;
  cp = cp * r2 - 1.0 / 3628800.0;
  cp = cp * r2 + 1.0 / 40320.0;
  cp = cp * r2 - 1.0 / 720.0;
  cp = cp * r2 + 1.0 / 24.0;
  cp = cp * r2 - 0.5;
  cp = 1.0 + r2 * cp;
  double s_, c_;
  if (n == 0) { s_ = sp; c_ = cp; }
  else if (n == 1) { s_ = cp; c_ = -sp; }
  else if (n == 2) { s_ = -sp; c_ = -cp; }
  else { s_ = -cp; c_ = sp; }
  sn = (float)s_; cs = (float)c_;
}

__device__ void wconv_tile(const float* __restrict__ W, const float* __restrict__ g, bf16_t* __restrict__ Wt, int N, int tile, float* lds, const int tid) {
  const int ntn = N >> 6;
  const int k0 = (tile / ntn) << 6, n0 = (tile % ntn) << 6;
  __syncthreads();
#pragma unroll
  for (int i = 0; i < 16; ++i) {
    const int k = i * 4 + (tid >> 6), n = tid & 63;
    float v = W[(size_t)(k0 + k) * N + n0 + n];
    if (g) v *= g[k0 + k];
    lds[k * 65 + n] = v;
  }
  __syncthreads();
#pragma unroll
  for (int i = 0; i < 16; ++i) {
    const int n = i * 4 + (tid >> 6), k = tid & 63;
    Wt[(size_t)(n0 + n) * 1024 + k0 + k] = (bf16_t)(pk2(lds[k * 65 + n], 0.f) & 0xffffu);
  }
}

template <bool FINAL>
__device__ void rms_rows(const float* X, bf16_t* H, float* O, const float* g) {
  const int t_ = opaque_tid();
  const int lane = t_ & 63;
  const int gw = (blockIdx.x * blockDim.x + t_) >> 6, nw = (gridDim.x * blockDim.x) >> 6;
  const __amdgpu_buffer_rsrc_t rsx = mk_rsrc(X);
  const __amdgpu_buffer_rsrc_t rso = mk_rsrc(FINAL ? (const void*)O : (const void*)X);
  constexpr int RB = 2;
  for (int rbase = gw; rbase < MTOK; rbase += nw * RB) {
    f32x4 v[RB][4];
#pragma unroll
    for (int q = 0; q < RB; ++q) {
      const int row = min(rbase + q * nw, MTOK - 1);
#pragma unroll
      for (int i = 0; i < 4; ++i) v[q][i] = __builtin_bit_cast(f32x4, ld16(rsx, ((size_t)row * DM + i * 256 + lane * 4) * 4));
    }
#pragma unroll
    for (int q = 0; q < RB; ++q) {
      const int row = rbase + q * nw;
      if (row < MTOK) {
        float ss = 0.f;
#pragma unroll
        for (int i = 0; i < 4; ++i) ss += v[q][i][0] * v[q][i][0] + v[q][i][1] * v[q][i][1] + v[q][i][2] * v[q][i][2] + v[q][i][3] * v[q][i][3];
#pragma unroll
        for (int o = 32; o >= 1; o >>= 1) ss += __shfl_xor(ss, o);
        const float rstd = rsqrtf(ss * (1.0f / DM) + EPSV);
#pragma unroll
        for (int i = 0; i < 4; ++i) {
          if (FINAL) {
            const f32x4 gg = *(const f32x4*)(g + i * 256 + lane * 4);
            f32x4 o = v[q][i] * rstd * gg;
            __builtin_amdgcn_raw_buffer_store_b128(__builtin_bit_cast(u32x4, o), rso, (int)(unsigned)(((size_t)row * DM + i * 256 + lane * 4) * 4), 0, 16);
          } else {
            u32x2 o;
            o[0] = pk2(v[q][i][0] * rstd, v[q][i][1] * rstd);
            o[1] = pk2(v[q][i][2] * rstd, v[q][i][3] * rstd);
            *(u32x2*)(H + (size_t)row * DM + i * 256 + lane * 4) = o;
          }
        }
      }
    }
  }
}

constexpr int LROW = 144;
template <bool SWAP>
DI void gemm_mainloop(const bf16_t* __restrict__ A, const bf16_t* __restrict__ Bm, int m0, int n0, char* lds, f32x16 (&acc)[1][2]) {
  const int tid = opaque_tid(), w = tid >> 6, lane = tid & 63, r = lane & 31, h = lane >> 5;
  const int wm = w & 3, wn = w >> 2;
#pragma unroll
  for (int j = 0; j < 2; ++j)
#pragma unroll
    for (int e = 0; e < 16; ++e) acc[0][j][e] = 0.f;
  u32x4 ra[2], rb[2];
  const __amdgpu_buffer_rsrc_t rsa = mk_rsrc(A), rsb = mk_rsrc(Bm);
  const unsigned oa = (unsigned)(((size_t)(m0 + (tid >> 3)) * 1024 + (tid & 7) * 8) * 2);
  const unsigned ob = (unsigned)(((size_t)(n0 + (tid >> 3)) * 1024 + (tid & 7) * 8) * 2);
#pragma unroll
  for (int i = 0; i < 2; ++i) {
    ra[i] = ld16(rsa, oa + i * 64 * 2048);
    rb[i] = ld16(rsb, ob + i * 64 * 2048);
  }
  const int soff = (tid >> 3) * LROW + (tid & 7) * 16;
  __syncthreads();
#pragma unroll
  for (int i = 0; i < 2; ++i) {
    *(u32x4*)(lds + soff + i * 64 * LROW) = ra[i];
    *(u32x4*)(lds + 128 * LROW + soff + i * 64 * LROW) = rb[i];
  }
#pragma unroll
  for (int i = 0; i < 2; ++i) {
    ra[i] = ld16(rsa, oa + i * 64 * 2048 + 128);
    rb[i] = ld16(rsb, ob + i * 64 * 2048 + 128);
  }
  __syncthreads();
  for (int kt = 0; kt < 16; ++kt) {
    const char* ldsA = lds + (kt & 1) * 256 * LROW;
    const char* ldsB = ldsA + 128 * LROW;
    char* nb = lds + ((kt + 1) & 1) * 256 * LROW;
    const bool st = (kt + 1 < 16), ldn = (kt + 2 < 16);
#pragma unroll
    for (int ks = 0; ks < 4; ++ks) {
      const bf16x8 af = *(const bf16x8*)(ldsA + (32 * wm + r) * LROW + (16 * ks + 8 * h) * 2);
      bf16x8 bfr[2];
#pragma unroll
      for (int j = 0; j < 2; ++j) bfr[j] = *(const bf16x8*)(ldsB + (64 * wn + 32 * j + r) * LROW + (16 * ks + 8 * h) * 2);
#pragma unroll
      for (int j = 0; j < 2; ++j) {
        if (SWAP) acc[0][j] = MFMA(bfr[j], af, acc[0][j]);
        else acc[0][j] = MFMA(af, bfr[j], acc[0][j]);
      }
      const int i = ks >> 1;
      if ((ks & 1) == 0) {
        if (st) *(u32x4*)(nb + soff + i * 64 * LROW) = ra[i];
        if (ldn) ra[i] = ld16(rsa, oa + i * 64 * 2048 + (kt + 2) * 128);
      } else {
        if (st) *(u32x4*)(nb + 128 * LROW + soff + i * 64 * LROW) = rb[i];
        if (ldn) rb[i] = ld16(rsb, ob + i * 64 * 2048 + (kt + 2) * 128);
      }
      __builtin_amdgcn_sched_barrier(0);
    }
    __syncthreads();
  }
}

__device__ void inproj_tile(const Params& p, int l, int tile, char* lds) {
  const int tid = opaque_tid(), w = tid >> 6, lane = tid & 63, r = lane & 31, h = lane >> 5;
  const int wm = w & 3, wn = w >> 2;
  const int nt = tile % 26, mt = tile / 26;
  const int m0 = mt * 128, n0 = nt * 128;
  const bf16_t* Hb = (const bf16_t*)(p.ws + OFF_H);
  const bf16_t* Wt = (const bf16_t*)(p.ws + OFF_WIN) + (size_t)l * DIN * 1024;
  const bool isV = (nt == 3) || (nt == 9) || (nt == 16) || (nt == 17) || (nt == 23);
  const int hc = (n0 >> 6) + wn;
  f32x16 acc[1][2];
  if (isV) {
    gemm_mainloop<false>(Hb, Wt, m0, n0, lds, acc);
    bf16_t* dst; int nh, vh;
    if (hc < 8) { dst = (bf16_t*)(p.ws + OFF_VA); nh = 2; vh = hc - 6; }
    else if (hc < 20) { dst = (bf16_t*)(p.ws + OFF_VB); nh = 2; vh = hc - 18; }
    else if (hc < 36) { dst = (bf16_t*)(p.ws + OFF_VC); nh = 4; vh = hc - 32; }
    else { dst = (bf16_t*)(p.ws + OFF_VD); nh = 2; vh = hc - 46; }
    const int b = m0 >> 13, s0 = (m0 & 8191) + 32 * wm;
    char* slab = lds + w * 5120;
#pragma unroll
    for (int j = 0; j < 2; ++j)
#pragma unroll
      for (int g = 0; g < 4; ++g) {
        u32x2 o;
        o[0] = pk2(acc[0][j][4 * g + 0], acc[0][j][4 * g + 1]);
        o[1] = pk2(acc[0][j][4 * g + 2], acc[0][j][4 * g + 3]);
        *(u32x2*)(slab + (32 * j + r) * 80 + (8 * g + 4 * h) * 2) = o;
      }
    asm volatile("s_waitcnt lgkmcnt(0)" ::: "memory");
    bf16_t* vbase = dst + ((size_t)(b * nh + vh) * 64) * SEQ + s0;
#pragma unroll
    for (int it = 0; it < 4; ++it) {
      const int idx = lane + 64 * it, d = idx >> 2, c = idx & 3;
      const u32x4 vv = *(const u32x4*)(slab + d * 80 + c * 16);
      *(u32x4*)(vbase + (size_t)d * SEQ + c * 8) = vv;
    }
    return;
  }
  gemm_mainloop<true>(Hb, Wt, m0, n0, lds, acc);
  int branch, idx;
  if (hc < 12) { branch = 0; idx = hc; }
  else if (hc < 24) { branch = 1; idx = hc - 12; }
  else if (hc < 40) { branch = 2; idx = hc - 24; }
  else { branch = 3; idx = hc - 40; }
  int kind, head;
  if (branch == 2) {
    if (idx < 4) { kind = 0; head = idx; } else if (idx < 8) { kind = 1; head = idx - 4; } else { kind = 3; head = idx - 12; }
  } else {
    if (idx < 4) { kind = 0; head = idx; } else if (idx < 6) { kind = 1; head = idx - 4; } else { kind = 3; head = idx - 8; }
  }
  constexpr int RROW = 272;
  const bool needs_rope = (kind != 3) && (branch != 2);
  if (needs_rope) {
    const int s0 = m0 & 8191;
    const __amdgpu_buffer_rsrc_t rst = mk_rsrc(p.ws + OFF_T32);
    if (branch == 0) {
      for (int idx = tid; idx < 66 * 16; idx += 512) {
        const int row = idx >> 4, c = idx & 15;
        const int pos = row < 64 ? row : (s0 >> 6) + (row - 64);
        *(u32x4*)(lds + row * RROW + c * 16) = ld16(rst, (size_t)(pos * 16 + c) * 16);
      }
      if (tid < 64) ((float*)(lds + 66 * RROW))[tid] = (kind == 0 ? p.qn_a : p.kn_a)[l * 64 + tid];
    } else {
      for (int idx = tid; idx < 128 * 16; idx += 512) {
        const int row = idx >> 4, c = idx & 15;
        *(u32x4*)(lds + row * RROW + c * 16) = ld16(rst, (size_t)((s0 + row) * 16 + c) * 16);
      }
    }
    __syncthreads();
  }
  const float* gl = (const float*)(lds + 66 * RROW);
#pragma unroll
  for (int i = 0; i < 1; ++i) {
    const int token = m0 + 32 * wm + r;
    const int tl = 32 * wm + r;
    const int b = token >> 13, s = token & 8191;
    f32x16 v0 = acc[i][0], v1 = acc[i][1];
    u32x2 pkd[2][4];
    const int token0 = m0 + 32 * wm;
    bf16_t* rowbase; int rstride;
    if (kind == 3) {
      rowbase = (bf16_t*)(p.ws + OFF_GATE) + (size_t)token0 * 1024 + branch * 256 + head * 64; rstride = 1024;
#pragma unroll
      for (int g = 0; g < 4; ++g) {
        float t[8];
#pragma unroll
        for (int e = 0; e < 4; ++e) {
          const float a0 = v0[4 * g + e], a1 = v1[4 * g + e];
          t[e] = a0 * __builtin_amdgcn_rcpf(1.f + __builtin_amdgcn_exp2f(-a0 * LOG2E));
          t[4 + e] = a1 * __builtin_amdgcn_rcpf(1.f + __builtin_amdgcn_exp2f(-a1 * LOG2E));
        }
        u32x2 o0, o1;
        o0[0] = pk2(t[0], t[1]); o0[1] = pk2(t[2], t[3]);
        o1[0] = pk2(t[4], t[5]); o1[1] = pk2(t[6], t[7]);
        pkd[0][g] = o0; pkd[1][g] = o1;
      }
    } else {
    if (branch == 0) {
      float ss = 0.f;
#pragma unroll
      for (int e = 0; e < 16; ++e) ss += v0[e] * v0[e] + v1[e] * v1[e];
      ss += xor32(ss);
      const float rstd = rsqrtf(ss * (1.f / 64.f) + EPSV);
#pragma unroll
      for (int e = 0; e < 16; ++e) {
        v0[e] = v0[e] * rstd * gl[crow(e, h)];
        v1[e] = v1[e] * rstd * gl[32 + crow(e, h)];
      }
    }
    if (branch == 0 || branch == 3) {
      const int row0 = (branch == 0) ? (64 + (tl >> 6)) : tl;
      const int row1 = (branch == 0) ? (tl & 63) : tl;
#pragma unroll
      for (int e = 0; e < 8; ++e) {
        const int jf = crow(e, h);
        const float2 c0 = *(const float2*)(lds + row0 * RROW + jf * 16);
        const float2 c1 = *(const float2*)(lds + row1 * RROW + jf * 16);
        const float a1 = v0[e], a2 = v0[e + 8];
        v0[e] = a1 * c0.x - a2 * c0.y; v0[e + 8] = a2 * c0.x + a1 * c0.y;
        const float b1 = v1[e], b2 = v1[e + 8];
        v1[e] = b1 * c1.x - b2 * c1.y; v1[e + 8] = b2 * c1.x + b1 * c1.y;
      }
    } else if (branch == 1) {
#pragma unroll
      for (int e = 0; e < 16; ++e) {
        const int jf = crow(e, h);
        const float2 c = *(const float2*)(lds + tl * RROW + jf * 8);
        const float a1 = v0[e], a2 = v1[e];
        v0[e] = a1 * c.x - a2 * c.y; v1[e] = a2 * c.x + a1 * c.y;
      }
    }
    float sc = 1.f;
    if (kind == 0) sc = (branch == 3) ? (0.17677669529663687f * LOG2E) : (0.125f * LOG2E);
    const int b0 = token0 >> 13, s0w = token0 & 8191;
    if (kind == 0) {
      const size_t qoff = (branch == 0) ? OFF_QA : (branch == 1) ? OFF_QB : (branch == 2) ? OFF_QC : OFF_QD;
      rowbase = (bf16_t*)(p.ws + qoff) + ((size_t)(b0 * 4 + head) * SEQ + s0w) * 64;
    } else {
      const size_t koff = (branch == 0) ? OFF_KA : (branch == 1) ? OFF_KB : (branch == 2) ? OFF_KC : OFF_KD;
      const int nh = (branch == 2) ? 4 : 2;
      rowbase = (bf16_t*)(p.ws + koff) + ((size_t)(b0 * nh + head) * SEQ + s0w) * 64;
    }
    rstride = 64;
#pragma unroll
    for (int g = 0; g < 4; ++g) {
      u32x2 o0, o1;
      o0[0] = pk2(v0[4 * g] * sc, v0[4 * g + 1] * sc); o0[1] = pk2(v0[4 * g + 2] * sc, v0[4 * g + 3] * sc);
      o1[0] = pk2(v1[4 * g] * sc, v1[4 * g + 1] * sc); o1[1] = pk2(v1[4 * g + 2] * sc, v1[4 * g + 3] * sc);
      pkd[0][g] = o0; pkd[1][g] = o1;
    }
    }
    char* slab = lds + 36864 + w * 4608;
#pragma unroll
    for (int j = 0; j < 2; ++j)
#pragma unroll
      for (int g = 0; g < 4; ++g) *(u32x2*)(slab + r * 144 + (32 * j + 8 * g + 4 * h) * 2) = pkd[j][g];
    asm volatile("s_waitcnt lgkmcnt(0)" ::: "memory");
#pragma unroll
    for (int it = 0; it < 4; ++it) {
      const int row = (lane >> 3) + 8 * it, c = lane & 7;
      const u32x4 vv = *(const u32x4*)(slab + row * 144 + c * 16);
      *(u32x4*)(rowbase + (size_t)row * rstride + c * 8) = vv;
    }
  }
}

__device__ void outproj_tile(const Params& p, int l, int tile, char* lds, const float* __restrict__ xin, float* __restrict__ xout) {
  const int tid = opaque_tid(), w = tid >> 6, lane = tid & 63, r = lane & 31, h = lane >> 5;
  const int wm = w & 3, wn = w >> 2;
  const int nt = tile & 7, mt = tile >> 3;
  const int m0 = mt * 128, n0 = nt * 128;
  const bf16_t* Mx = (const bf16_t*)(p.ws + OFF_MIX);
  const bf16_t* Wt = (const bf16_t*)(p.ws + OFF_WOUT) + (size_t)l * 1024 * 1024;
  f32x16 acc[1][2];
  const __amdgpu_buffer_rsrc_t rsxin = mk_rsrc(xin);
  gemm_mainloop<false>(Mx, Wt, m0, n0, lds, acc);
#pragma unroll
  for (int i = 0; i < 1; ++i)
#pragma unroll
    for (int j = 0; j < 2; ++j) {
      const int n = n0 + 64 * wn + 32 * j + r;
#pragma unroll
      for (int e = 0; e < 16; ++e) {
        const int m = m0 + 32 * wm + crow(e, h);
        const size_t o = (size_t)m * DM + n;
        xout[o] = __uint_as_float(ld4(rsxin, o * 4)) + acc[i][j][e];
      }
    }
}

enum { MA = 0, MB = 1, MC = 2, MD = 3 };

template <int MODE>
__device__ void attn_item(const Params& p, int l, int item, char* lds) {
  const int tid = opaque_tid(), w = tid >> 6, lane = tid & 63, r = lane & 31, h = lane >> 5;
  const int qg = w & 3, role = w >> 2;
  constexpr int NKS = (MODE == MD) ? 2 : 4;
  constexpr bool FAST = (MODE == MA || MODE == MD);
  constexpr bool NEGM = FAST;
  constexpr float P_THR = 256.f;
  float* ldsR = (float*)(lds + 256 * LROW);

  int b, qtok, ktlo, kthi, head_out, koff = 0;
  const bf16_t *Qp, *Kg, *Vg;
  int qrow = 0, rs = 0, qcol0 = 0;
  if (MODE == MA || MODE == MB) {
    b = item >> 7; const int kvh = (item >> 6) & 1, qb = item & 63;
    qtok = qb * 128 + 32 * qg + r;
    head_out = kvh * 2 + role;
    Qp = (const bf16_t*)(p.ws + (MODE == MA ? OFF_QA : OFF_QB)) + ((size_t)(b * 4 + head_out) * SEQ + qtok) * 64 + 8 * h;
    const int kvrow = b * 2 + kvh;
    Kg = (const bf16_t*)(p.ws + (MODE == MA ? OFF_KA : OFF_KB)) + (size_t)kvrow * SEQ * 64;
    Vg = (const bf16_t*)(p.ws + (MODE == MA ? OFF_VA : OFF_VB)) + (size_t)kvrow * 64 * SEQ;
    if (MODE == MA) { ktlo = 0; kthi = 128; }
    else { ktlo = max(0, qb * 2 - 2); kthi = min(128, qb * 2 + 4); }
  } else if (MODE == MD) {
    b = item >> 8; const int hq = (item >> 6) & 3, qb = item & 63;
    qtok = qb * 128 + 32 * qg + r;
    head_out = hq;
    koff = 32 * role;
    Qp = (const bf16_t*)(p.ws + OFF_QD) + ((size_t)(b * 4 + hq) * SEQ + qtok) * 64 + koff + 8 * h;
    const int kvrow = b * 2 + (hq >> 1);
    Kg = (const bf16_t*)(p.ws + OFF_KD) + (size_t)kvrow * SEQ * 64;
    Vg = (const bf16_t*)(p.ws + OFF_VD) + (size_t)kvrow * 64 * SEQ;
    ktlo = 0; kthi = 128;
  } else {
    b = item >> 7; const int hh = (item >> 5) & 3, rg = item & 31;
    qrow = rg * 4 + qg;
    rs = min(max(qrow - 4, 0), 120);
    qcol0 = 32 * role;
    qtok = qrow * 64 + qcol0 + r;
    head_out = hh;
    Qp = (const bf16_t*)(p.ws + OFF_QC) + ((size_t)(b * 4 + hh) * SEQ + qtok) * 64 + 8 * h;
    const int kvrow = b * 4 + hh;
    Kg = (const bf16_t*)(p.ws + OFF_KC) + (size_t)kvrow * SEQ * 64;
    Vg = (const bf16_t*)(p.ws + OFF_VC) + (size_t)kvrow * 64 * SEQ;
    ktlo = min(max(rg * 4 - 4, 0), 120);
    kthi = min(max(rg * 4 + 3 - 4, 0), 120) + 8;
    const float* rp = p.rpb_c + ((size_t)l * 4 + hh) * 465;
    for (int i = tid; i < 465; i += 512) ldsR[i] = rp[i] * LOG2E;
  }

  const __amdgpu_buffer_rsrc_t rsw = mk_rsrc(p.ws);
  bf16x8 qf[NKS];
#pragma unroll
  for (int ks = 0; ks < NKS; ++ks) qf[ks] = __builtin_bit_cast(bf16x8, ld16(rsw, (size_t)((const char*)(Qp + 16 * ks) - p.ws)));

  f32x16 O[2];
#pragma unroll
  for (int db = 0; db < 2; ++db)
#pragma unroll
    for (int e = 0; e < 16; ++e) O[db][e] = 0.f;
  float mrun, lrun;
  if (MODE == MB) { mrun = p.sink_b[l * 4 + head_out] * LOG2E; lrun = 0.5f; }
  else { mrun = NEG; lrun = 0.f; }
  f32x16 negm;
  if (FAST) {
    f32x16 s0;
#pragma unroll
    for (int e = 0; e < 16; ++e) s0[e] = 0.f;
#pragma unroll
    for (int ks = 0; ks < NKS; ++ks) {
      const bf16_t* kp = Kg + ((size_t)ktlo * 64 + r) * 64 + koff + 16 * ks + 8 * h;
      const bf16x8 k0 = __builtin_bit_cast(bf16x8, ld16(rsw, (size_t)((const char*)kp - p.ws)));
      s0 = MFMA(k0, qf[ks], s0);
    }
    float m0 = s0[0];
#pragma unroll
    for (int e = 1; e < 16; ++e) m0 = fmaxf(m0, s0[e]);
    m0 = fmaxf(m0, xor32(m0));
    mrun = m0;
#pragma unroll
    for (int e = 0; e < 16; ++e) negm[e] = -m0;
  }
  u32x4 kreg, vreg;
  const int lrow = tid >> 3, lch = tid & 7;
  const bf16_t* kgp = Kg + (size_t)lrow * 64 + lch * 8;
  const bf16_t* vgp = Vg + (size_t)lrow * SEQ + lch * 8;
  kreg = ld16(rsw, (size_t)((const char*)(kgp + (size_t)ktlo * 64 * 64) - p.ws));
  vreg = ld16(rsw, (size_t)((const char*)(vgp + ktlo * 64) - p.ws));
  const int soff = lrow * LROW + lch * 16;
  const int vsoff = lrow * LROW + (lch >> 1) * 32 + (lch & 1) * 8;

  __syncthreads();
  *(u32x4*)(lds + soff) = kreg;
  { u32x2 lo_ = {vreg[0], vreg[1]}, hi_ = {vreg[2], vreg[3]}; *(u32x2*)(lds + 64 * LROW + vsoff) = lo_; *(u32x2*)(lds + 64 * LROW + vsoff + 16) = hi_; }
  if (ktlo + 1 < kthi) {
    kreg = ld16(rsw, (size_t)((const char*)(kgp + (size_t)(ktlo + 1) * 64 * 64) - p.ws));
    vreg = ld16(rsw, (size_t)((const char*)(vgp + (ktlo + 1) * 64) - p.ws));
  }
  __syncthreads();
  for (int kt = ktlo; kt < kthi; ++kt) {
    const int cur = (kt - ktlo) & 1;
    const char* ldsK = lds + cur * 128 * LROW;
    const char* ldsV = ldsK + 64 * LROW;
    if (kt + 1 < kthi) {
      char* nb = lds + (cur ^ 1) * 128 * LROW;
      *(u32x4*)(nb + soff) = kreg;
      { u32x2 lo_ = {vreg[0], vreg[1]}, hi_ = {vreg[2], vreg[3]}; *(u32x2*)(nb + 64 * LROW + vsoff) = lo_; *(u32x2*)(nb + 64 * LROW + vsoff + 16) = hi_; }
    }
    if (kt + 2 < kthi) {
      kreg = ld16(rsw, (size_t)((const char*)(kgp + (size_t)(kt + 2) * 64 * 64) - p.ws));
      vreg = ld16(rsw, (size_t)((const char*)(vgp + (kt + 2) * 64) - p.ws));
    }
    bool active = true;
    if (MODE == MC) active = (kt >= rs) && (kt < rs + 8);
    if (active) {
#pragma nounroll
      for (int kb = 0; kb < 2; ++kb) {
        bf16x8 pf[2];
        if (FAST) {
          f32x16 S = negm;
#pragma unroll
          for (int ks = 0; ks < NKS; ++ks) {
            const bf16x8 k0 = *(const bf16x8*)(ldsK + (32 * kb + r) * LROW + (koff + 16 * ks + 8 * h) * 2);
            S = MFMA(k0, qf[ks], S);
          }
          float ls = 0.f;
#pragma unroll
          for (int e = 0; e < 16; ++e) { S[e] = __builtin_amdgcn_exp2f(S[e]); ls += S[e]; }
          if (__any(!(ls <= P_THR))) {
            S = negm;
#pragma unroll
            for (int ks = 0; ks < NKS; ++ks) {
              const bf16x8 k0 = *(const bf16x8*)(ldsK + (32 * kb + r) * LROW + (koff + 16 * ks + 8 * h) * 2);
              S = MFMA(k0, qf[ks], S);
            }
            float mx = S[0];
#pragma unroll
            for (int e = 1; e < 16; ++e) mx = fmaxf(mx, S[e]);
            mx = fmaxf(mx, xor32(mx));
            const float d = fmaxf(mx, 0.f);
            const float alpha = __builtin_amdgcn_exp2f(-d);
            mrun += d;
            lrun *= alpha;
#pragma unroll
            for (int db = 0; db < 2; ++db)
#pragma unroll
              for (int e = 0; e < 16; ++e) O[db][e] *= alpha;
#pragma unroll
            for (int e = 0; e < 16; ++e) negm[e] -= d;
            ls = 0.f;
#pragma unroll
            for (int e = 0; e < 16; ++e) { S[e] = __builtin_amdgcn_exp2f(S[e] - d); ls += S[e]; }
          }
#pragma unroll
          for (int s = 0; s < 2; ++s) {
            u32x4 pk;
            pk[0] = pk2(S[8 * s + 0], S[8 * s + 1]); pk[1] = pk2(S[8 * s + 2], S[8 * s + 3]);
            pk[2] = pk2(S[8 * s + 4], S[8 * s + 5]); pk[3] = pk2(S[8 * s + 6], S[8 * s + 7]);
            pf[s] = __builtin_bit_cast(bf16x8, pk);
          }
          lrun += ls;
        } else {
          f32x16 S;
#pragma unroll
          for (int e = 0; e < 16; ++e) S[e] = 0.f;
#pragma unroll
          for (int ks = 0; ks < NKS; ++ks) {
            const bf16x8 k0 = *(const bf16x8*)(ldsK + (32 * kb + r) * LROW + (16 * ks + 8 * h) * 2);
            S = MFMA(k0, qf[ks], S);
          }
          if (MODE == MB) {
#pragma unroll
            for (int e = 0; e < 16; ++e) {
              const int kpos = kt * 64 + 32 * kb + crow(e, h);
              const int dlt = qtok - kpos;
              const bool ok = (dlt <= 128) && (dlt >= -128);
              S[e] = ok ? S[e] : NEG;
            }
          }
          if (MODE == MC) {
            const int dr = kt - qrow + 7;
            const int qcol = qcol0 + r;
            const int cs = min(max(qcol - 8, 0), 48);
#pragma unroll
            for (int e = 0; e < 16; ++e) {
              const int kcol = 32 * kb + crow(e, h);
              const bool ok = (kcol >= cs) && (kcol < cs + 16);
              const int dc = min(max(kcol - qcol, -15), 15) + 15;
              const float bias = ldsR[dr * 31 + dc];
              S[e] = ok ? (S[e] + bias) : NEG;
            }
          }
          float mx = S[0];
#pragma unroll
          for (int e = 1; e < 16; ++e) mx = fmaxf(mx, S[e]);
          mx = fmaxf(mx, xor32(mx));
          if (__any(mx > mrun)) {
            const float mn = fmaxf(mrun, mx);
            const float alpha = __builtin_amdgcn_exp2f(mrun - mn);
            mrun = mn;
            lrun *= alpha;
#pragma unroll
            for (int db = 0; db < 2; ++db)
#pragma unroll
              for (int e = 0; e < 16; ++e) O[db][e] *= alpha;
          }
          const float mn = mrun;
          float ls = 0.f;
#pragma unroll
          for (int e = 0; e < 16; ++e) {
            const float pvv = __builtin_amdgcn_exp2f(S[e] - mn);
            S[e] = pvv;
            ls += pvv;
          }
          lrun += ls;
#pragma unroll
          for (int s = 0; s < 2; ++s) {
            u32x4 pk;
            pk[0] = pk2(S[8 * s + 0], S[8 * s + 1]); pk[1] = pk2(S[8 * s + 2], S[8 * s + 3]);
            pk[2] = pk2(S[8 * s + 4], S[8 * s + 5]); pk[3] = pk2(S[8 * s + 6], S[8 * s + 7]);
            pf[s] = __builtin_bit_cast(bf16x8, pk);
          }
        }
#pragma unroll
        for (int s = 0; s < 2; ++s)
#pragma unroll
          for (int db = 0; db < 2; ++db) {
            const bf16x8 vf = *(const bf16x8*)(ldsV + (32 * db + r) * LROW + (32 * kb + 16 * s) * 2 + 16 * h);
            O[db] = MFMA(vf, pf[s], O[db]);
          }
      }
    }
    __syncthreads();
  }

  bf16_t* mix = (bf16_t*)(p.ws + OFF_MIX);
  lrun += xor32(lrun);
  const float inv = 1.f / lrun;
  if (MODE == MD) {
    float* xch = (float*)lds + (size_t)qg * 32 * 64 + lane;
    __syncthreads();
    if (role == 1) {
#pragma unroll
      for (int db = 0; db < 2; ++db)
#pragma unroll
        for (int e = 0; e < 16; ++e) xch[(db * 16 + e) * 64] = O[db][e] * inv;
    }
    __syncthreads();
    if (role == 1) return;
    const float lam = __uint_as_float(ld4(rsw, OFF_CTRL + (16 + l * 2 + 0) * 4)), omli = __uint_as_float(ld4(rsw, OFF_CTRL + (16 + l * 2 + 1) * 4));
    f32x16 o[2];
    float ss = 0.f;
#pragma unroll
    for (int db = 0; db < 2; ++db)
#pragma unroll
      for (int e = 0; e < 16; ++e) {
        const float t = O[db][e] * inv - lam * xch[(db * 16 + e) * 64];
        o[db][e] = t;
        ss += t * t;
      }
    ss += xor32(ss);
    const float rstd = rsqrtf(ss * (1.f / 64.f) + EPSV) * omli;
    const size_t base = (size_t)(b * SEQ + qtok) * 1024 + 768 + head_out * 64 + 4 * h;
    const float* sg = p.subln + l * 64 + 4 * h;
#pragma unroll
    for (int db = 0; db < 2; ++db)
#pragma unroll
      for (int g = 0; g < 4; ++g) {
        const size_t off = base + 32 * db + 8 * g;
        const u32x2 gv = ld8(rsw, OFF_GATE + off * 2);
        const float g0 = __uint_as_float(gv[0] << 16), g1 = __uint_as_float(gv[0] & 0xffff0000u);
        const float g2 = __uint_as_float(gv[1] << 16), g3 = __uint_as_float(gv[1] & 0xffff0000u);
        const float* sgp = sg + 32 * db + 8 * g;
        u32x2 ov;
        ov[0] = pk2(o[db][4 * g + 0] * rstd * sgp[0] * g0, o[db][4 * g + 1] * rstd * sgp[1] * g1);
        ov[1] = pk2(o[db][4 * g + 2] * rstd * sgp[2] * g2, o[db][4 * g + 3] * rstd * sgp[3] * g3);
        *(u32x2*)(mix + off) = ov;
      }
  } else {
    const int brc = (MODE == MA) ? 0 : (MODE == MB) ? 256 : 512;
    const size_t base = (size_t)(b * SEQ + qtok) * 1024 + brc + head_out * 64 + 4 * h;
#pragma unroll
    for (int db = 0; db < 2; ++db)
#pragma unroll
      for (int g = 0; g < 4; ++g) {
        const size_t off = base + 32 * db + 8 * g;
        const u32x2 gv = ld8(rsw, OFF_GATE + off * 2);
        const float g0 = __uint_as_float(gv[0] << 16), g1 = __uint_as_float(gv[0] & 0xffff0000u);
        const float g2 = __uint_as_float(gv[1] << 16), g3 = __uint_as_float(gv[1] & 0xffff0000u);
        u32x2 ov;
        ov[0] = pk2(O[db][4 * g + 0] * inv * g0, O[db][4 * g + 1] * inv * g1);
        ov[1] = pk2(O[db][4 * g + 2] * inv * g2, O[db][4 * g + 3] * inv * g3);
        *(u32x2*)(mix + off) = ov;
      }
  }
}

constexpr int N_D = 512, N_A = 256, N_B = 256, N_C = 256;
constexpr int N_ATT = N_D + N_A + N_B + N_C;

__device__ void phase_prep(const Params& p, char* lds) {
  const int tid = opaque_tid();
  const int gtid = blockIdx.x * blockDim.x + tid, nth = gridDim.x * blockDim.x;
  if (blockIdx.x == 0 && tid == 0) {
    float* cf = (float*)(p.ws + OFF_CTRL) + 16;
    for (int l = 0; l < 2; ++l) {
      float s1 = 0.f, s2 = 0.f;
      for (int i = 0; i < 32; ++i) { s1 += p.lq1[l * 32 + i] * p.lk1[l * 32 + i]; s2 += p.lq2[l * 32 + i] * p.lk2[l * 32 + i]; }
      const float li = (l == 0) ? 0.2f : 0.35550906759096934f;
      cf[l * 2 + 0] = __expf(s1) - __expf(s2) + li;
      cf[l * 2 + 1] = 1.0f - li;
    }
  }
  float2* T32 = (float2*)(p.ws + OFF_T32);
  for (int i = gtid; i < SEQ * 32; i += nth) {
    const int pos = i >> 5, j = i & 31;
    const float ang = (float)pos * INV32[j];
    float sn, cs;
    sincos_d(ang, sn, cs);
    T32[i] = make_float2(cs, sn);
  }
  const int half = tid >> 8, tl = tid & 255;
  for (int tp = blockIdx.x; tp < 832 + 256; tp += gridDim.x) {
    const int t = 2 * tp + half;
    const int l = t / 1088, tt = t % 1088;
    float* lf = (float*)(lds + half * 20480);
    if (tt < 832) wconv_tile(p.w_in + (size_t)l * 1024 * DIN, p.norm_g + l * 1024, (bf16_t*)(p.ws + OFF_WIN) + (size_t)l * DIN * 1024, DIN, tt, lf, tl);
    else wconv_tile(p.w_out + (size_t)l * 1024 * 1024, nullptr, (bf16_t*)(p.ws + OFF_WOUT) + (size_t)l * 1024 * 1024, 1024, tt - 832, lf, tl);
  }
  rms_rows<false>(p.x, (bf16_t*)(p.ws + OFF_H), nullptr, nullptr);
}

__device__ void phase_inproj(const Params& p, int l, char* lds) {
  if ((gridDim.x & 7) == 0) {
    const int xcd = blockIdx.x & 7, slot = blockIdx.x >> 3, slots = gridDim.x >> 3;
    for (int q = slot; q < 16 * 26; q += slots) {
      int mtl, nt;
      if (q < 384) { const int ng = q >> 7, rem = q & 127, w8 = rem & 63; mtl = (rem >> 6) * 8 + (w8 & 7); nt = ng * 8 + (w8 >> 3); }
      else { const int rem = q - 384; mtl = rem & 15; nt = 24 + (rem >> 4); }
      inproj_tile(p, l, (xcd * 16 + mtl) * 26 + nt, lds);
    }
  } else {
    for (int t = blockIdx.x; t < 128 * 26; t += gridDim.x) inproj_tile(p, l, t, lds);
  }
}

DI int fetch_item(unsigned* ctr, int* s_item) {
  __syncthreads();
  if (threadIdx.x == 0) *s_item = (int)atomicAdd(ctr, 1u);
  __syncthreads();
  return *s_item;
}

__device__ void phase_attn(const Params& p, int l, char* lds, int* s_item, int cidx) {
  unsigned* ctr = (unsigned*)(p.ws + OFF_CTRL) + cidx;
  int item = blockIdx.x;
  while (item < N_A) { attn_item<MA>(p, l, item, lds); item = (int)gridDim.x + fetch_item(ctr, s_item); }
  while (item < N_A + N_D) { attn_item<MD>(p, l, item - N_A, lds); item = (int)gridDim.x + fetch_item(ctr, s_item); }
  while (item < N_A + N_D + N_B) { attn_item<MB>(p, l, item - N_A - N_D, lds); item = (int)gridDim.x + fetch_item(ctr, s_item); }
  while (item < N_ATT) { attn_item<MC>(p, l, item - N_A - N_D - N_B, lds); item = (int)gridDim.x + fetch_item(ctr, s_item); }
}

__device__ void phase_outproj(const Params& p, int l, char* lds) {
  const float* xin = (l == 0) ? p.x : (const float*)(p.ws + OFF_X1);
  float* xout = (l == 0) ? (float*)(p.ws + OFF_X1) : p.out;
  if ((gridDim.x & 7) == 0) {
    const int xcd = blockIdx.x & 7, slot = blockIdx.x >> 3, slots = gridDim.x >> 3;
    for (int q = slot; q < 16 * 8; q += slots) {
      const int w8 = q & 63, mtl = (q >> 6) * 8 + (w8 & 7), nt = w8 >> 3;
      outproj_tile(p, l, (xcd * 16 + mtl) * 8 + nt, lds, xin, xout);
    }
  } else {
    for (int t = blockIdx.x; t < 128 * 8; t += gridDim.x) outproj_tile(p, l, t, lds, xin, xout);
  }
}

__global__ void __launch_bounds__(512, 4) fwd_megakernel(Params p) {
  __shared__ __attribute__((aligned(16))) char lds[4 * 128 * LROW];
  __shared__ int s_item;
  __shared__ uint4 xb_words;
  if (p.ws == nullptr) cg::this_grid().sync();
  if (threadIdx.x == 0) xb_words = make_uint4(0u, 0u, 0u, 0u);
  __syncthreads();
  XcdBarrier gb = xcd_barrier_post((unsigned*)(p.ws + OFF_BAR), (volatile LAS unsigned*)&xb_words);
  phase_prep(p, lds);
  xcd_barrier(gb);
  for (int l = 0; l < 2; ++l) {
    phase_inproj(p, l, lds);
    xcd_barrier(gb);
    phase_attn(p, l, lds, &s_item, l);
    xcd_barrier(gb);
#ifdef PROBE_ATTN2
    phase_attn(p, l, lds, &s_item, l + 2);
    xcd_barrier(gb);
#endif
#ifdef PROBE_GEMM2
    phase_inproj(p, l, lds);
    xcd_barrier(gb);
#endif
    phase_outproj(p, l, lds);
    xcd_barrier(gb);
    if (l == 0) {
      rms_rows<false>((const float*)(p.ws + OFF_X1), (bf16_t*)(p.ws + OFF_H), nullptr, nullptr);
      xcd_barrier(gb);
    } else {
      rms_rows<true>(p.out, nullptr, p.out, p.final_g);
    }
  }
}

extern "C" void kernel_launch(void* const* d_in, const int* in_sizes, int n_in, void* d_out,
                              int out_size, void* d_ws, size_t ws_size, hipStream_t stream) {
  static int grid_blocks = 0;
  if (!grid_blocks) {
    int dev = 0, cus = 0, per_cu = 0;
    (void)hipGetDevice(&dev);
    (void)hipDeviceGetAttribute(&cus, hipDeviceAttributeMultiprocessorCount, dev);
    (void)hipOccupancyMaxActiveBlocksPerMultiprocessor(&per_cu, fwd_megakernel, 512, 0);
    if (per_cu > 2) per_cu = 2;
    if (per_cu < 1) per_cu = 1;
    grid_blocks = cus * per_cu;
  }
  if (ws_size < WS_NEEDED) { fprintf(stderr, "workspace too small\n"); return; }
  Params p{};
  p.x = (const float*)d_in[0]; p.norm_g = (const float*)d_in[1]; p.w_in = (const float*)d_in[2]; p.w_out = (const float*)d_in[3];
  p.qn_a = (const float*)d_in[4]; p.kn_a = (const float*)d_in[5]; p.sink_b = (const float*)d_in[6]; p.rpb_c = (const float*)d_in[7];
  p.lq1 = (const float*)d_in[8]; p.lk1 = (const float*)d_in[9]; p.lq2 = (const float*)d_in[10]; p.lk2 = (const float*)d_in[11];
  p.subln = (const float*)d_in[12]; p.final_g = (const float*)d_in[13];
  p.out = (float*)d_out; p.ws = (char*)d_ws;
  (void)hipMemsetAsync(d_ws, 0, OFF_T32, stream);
  void* args[] = {&p};
  hipError_t e = hipLaunchCooperativeKernel((void*)fwd_megakernel, dim3(grid_blocks), dim3(512), args, 0, stream);
  if (e != hipSuccess) fprintf(stderr, "cooperative launch failed: %s (grid %d)\n", hipGetErrorString(e), grid_blocks);
}
```

```cpp
#include <hip/hip_runtime.h>
#include <hip/hip_cooperative_groups.h>
#include <cstdio>
#include <cstdint>
namespace cg = cooperative_groups;

#define DI __device__ __forceinline__
typedef unsigned short bf16_t;
typedef short bf16x8 __attribute__((ext_vector_type(8)));
typedef short s16x4 __attribute__((ext_vector_type(4)));
typedef float f32x16 __attribute__((ext_vector_type(16)));
typedef float f32x4 __attribute__((ext_vector_type(4)));
typedef float f32x2 __attribute__((ext_vector_type(2)));
typedef __bf16 bf16x2_t __attribute__((ext_vector_type(2)));
typedef unsigned u32x2 __attribute__((ext_vector_type(2)));
typedef unsigned u32x4 __attribute__((ext_vector_type(4)));

#define MFMA(a, b, c) __builtin_amdgcn_mfma_f32_32x32x16_bf16((a), (b), (c), 0, 0, 0)

constexpr int SEQ = 8192, DM = 1024, DIN = 3328, MTOK = 16384;
constexpr float LOG2E = 1.4426950408889634f;
constexpr float EPSV = 1e-6f;
constexpr float NEG = -1e30f;

constexpr size_t MiB = 1024 * 1024;
constexpr size_t OFF_BAR = 0;
constexpr size_t OFF_CTRL = 16384;
constexpr size_t OFF_T32 = 20480;
constexpr size_t OFF_WIN = OFF_T32 + 2 * MiB;
constexpr size_t OFF_WOUT = OFF_WIN + 13 * MiB;
constexpr size_t OFF_H = OFF_WOUT + 4 * MiB;
constexpr size_t OFF_QA = OFF_H + 32 * MiB;
constexpr size_t OFF_KA = OFF_QA + 8 * MiB;
constexpr size_t OFF_VA = OFF_KA + 4 * MiB;
constexpr size_t OFF_QB = OFF_VA + 4 * MiB;
constexpr size_t OFF_KB = OFF_QB + 8 * MiB;
constexpr size_t OFF_VB = OFF_KB + 4 * MiB;
constexpr size_t OFF_QC = OFF_VB + 4 * MiB;
constexpr size_t OFF_KC = OFF_QC + 8 * MiB;
constexpr size_t OFF_VC = OFF_KC + 8 * MiB;
constexpr size_t OFF_QD = OFF_VC + 8 * MiB;
constexpr size_t OFF_KD = OFF_QD + 8 * MiB;
constexpr size_t OFF_VD = OFF_KD + 4 * MiB;
constexpr size_t OFF_GATE = OFF_VD + 4 * MiB;
constexpr size_t OFF_X1 = OFF_GATE + 32 * MiB;
constexpr size_t OFF_MIX = OFF_X1 + 64 * MiB;
constexpr size_t WS_NEEDED = OFF_MIX + 32 * MiB;

struct Params {
  const float *x, *norm_g, *w_in, *w_out, *qn_a, *kn_a, *sink_b, *rpb_c, *lq1, *lk1, *lq2, *lk2, *subln, *final_g;
  float* out;
  char* ws;
};

__device__ const float INV32[32] = {
    1.000000000e+00f, 7.498942614e-01f, 5.623413324e-01f, 4.216965139e-01f, 3.162277639e-01f, 2.371373773e-01f,
    1.778279394e-01f, 1.333521307e-01f, 1.000000015e-01f, 7.498941571e-02f, 5.623413250e-02f, 4.216965288e-02f,
    3.162277490e-02f, 2.371373773e-02f, 1.778279431e-02f, 1.333521493e-02f, 9.999999776e-03f, 7.498941850e-03f,
    5.623413250e-03f, 4.216964822e-03f, 3.162277630e-03f, 2.371373586e-03f, 1.778279431e-03f, 1.333521446e-03f,
    1.000000047e-03f, 7.498942432e-04f, 5.623413017e-04f, 4.216965172e-04f, 3.162277571e-04f, 2.371373703e-04f,
    1.778279402e-04f, 1.333521504e-04f};

DI unsigned pk2(float a, float b) {
  f32x2 v = {a, b};
  return __builtin_bit_cast(unsigned, __builtin_convertvector(v, bf16x2_t));
}
DI float bf2f(unsigned short u) { return __uint_as_float(((unsigned)u) << 16); }
DI int crow(int reg, int h) { return (reg & 3) + 8 * (reg >> 2) + 4 * h; }
DI float xor32(float v) { return __shfl_xor(v, 32); }
DI __amdgpu_buffer_rsrc_t mk_rsrc(const void* base) { return __builtin_amdgcn_make_buffer_rsrc((void*)base, 0, 0x7fffffff, 0x00020000); }
DI u32x4 ld16(__amdgpu_buffer_rsrc_t rs, size_t byte_off) { return __builtin_amdgcn_raw_buffer_load_b128(rs, (int)(unsigned)byte_off, 0, 16); }
DI u32x2 ld8(__amdgpu_buffer_rsrc_t rs, size_t byte_off) { return __builtin_amdgcn_raw_buffer_load_b64(rs, (int)(unsigned)byte_off, 0, 16); }
DI unsigned ld4(__amdgpu_buffer_rsrc_t rs, size_t byte_off) { return __builtin_amdgcn_raw_buffer_load_b32(rs, (int)(unsigned)byte_off, 0, 16); }
DI int opaque_tid() { int t = threadIdx.x; asm volatile("" : "+v"(t)); return t; }


#define XB_TMO      128
#define XB_XCNT(j)  (256  + 64 * (j))
#define XB_XSUB(j)  (1280 + 64 * (j))
#define XB_XGEN(j)  (2304 + 64 * (j))
#define XB_TOP      3328
#define XB_TOPGEN   3392
#define XCD_BAR_WORDS 3456
#define XB_SPIN_CAP (1u << 20)
#define LAS __attribute__((address_space(3)))
DI unsigned xb_ld(unsigned* p) { return __hip_atomic_load(p, __ATOMIC_RELAXED, __HIP_MEMORY_SCOPE_AGENT); }
DI unsigned xb_add(unsigned* p, unsigned v) { return __hip_atomic_fetch_add(p, v, __ATOMIC_RELAXED, __HIP_MEMORY_SCOPE_AGENT); }
DI unsigned xb_xcc_id() { return (unsigned)__builtin_amdgcn_s_getreg((3 << 11) | 20) & 0xFu; }
#define XB_SPIN(cond, bar) do { unsigned _sp = 0; while (cond) { __builtin_amdgcn_s_sleep(1); \
    if ((++_sp & 255u) == 0u) { if (xb_ld(&(bar)[XB_TMO])) break; if (_sp > XB_SPIN_CAP) { atomicAdd(&(bar)[XB_TMO], 1u); break; } } } } while (0)
struct XcdBarrier { unsigned* bar; unsigned x; volatile LAS unsigned* st; };
DI XcdBarrier xcd_barrier_post(unsigned* bar, volatile LAS unsigned* st) {
  XcdBarrier b; b.bar = bar; b.x = xb_xcc_id(); b.st = st;
  if (threadIdx.x == 0) (void)xb_add(&bar[XB_XCNT(b.x)], 1u);
  return b;
}
DI void xcd_barrier_complete(unsigned* bar, unsigned x, unsigned& nloc, unsigned& nx) {
  const unsigned G = gridDim.x * gridDim.y * gridDim.z;
  unsigned sum, cnt, mine, sp = 0u;
  for (;;) {
    sum = 0u; cnt = 0u; mine = 0u;
#pragma unroll
    for (unsigned j = 0; j < 16; ++j) { const unsigned c = xb_ld(&bar[XB_XCNT(j)]); sum += c; cnt += (c > 0u) ? 1u : 0u; mine = (j == x) ? c : mine; }
    if (sum == G) break;
    __builtin_amdgcn_s_sleep(1);
    if ((++sp & 255u) == 0u) { if (xb_ld(&bar[XB_TMO])) break; if (sp > XB_SPIN_CAP) { atomicAdd(&bar[XB_TMO], 1u); break; } }
  }
  nloc = mine > 0u ? mine : 1u; nx = cnt > 0u ? cnt : 1u;
}
DI void xcd_barrier(const XcdBarrier& b) {
  asm volatile("s_waitcnt vmcnt(0)" ::: "memory");
  __syncthreads();
  if (threadIdx.x == 0) {
    unsigned* bar = b.bar;
    asm volatile("" : "+s"(bar));
    __builtin_amdgcn_s_waitcnt(0);
    unsigned nloc = b.st[0], nx = b.st[1];
    if (nloc == 0u) { xcd_barrier_complete(bar, b.x, nloc, nx); b.st[0] = nloc; b.st[1] = nx; }
    unsigned bx = b.x;
    asm volatile("" : "+s"(bx));
    const unsigned old = xb_add(&bar[XB_XSUB(bx)], 1u);
    const unsigned gen = old / nloc;
    if (old + 1u == (gen + 1u) * nloc) {
      __builtin_amdgcn_fence(__ATOMIC_RELEASE, "agent");
      asm volatile("s_waitcnt vmcnt(0)" ::: "memory");
      const unsigned og = xb_add(&bar[XB_TOP], 1u);
      const unsigned tg = og / nx;
      if (og + 1u == (tg + 1u) * nx) xb_add(&bar[XB_TOPGEN], 1u);
      else XB_SPIN(xb_ld(&bar[XB_TOPGEN]) == tg, bar);
      __builtin_amdgcn_fence(__ATOMIC_ACQUIRE, "agent");
      xb_add(&bar[XB_XGEN(bx)], 1u);
      asm volatile("s_waitcnt vmcnt(0)" ::: "memory");
    } else {
      XB_SPIN(xb_ld(&bar[XB_XGEN(bx)]) == gen, bar);
      __builtin_amdgcn_fence(__ATOMIC_ACQUIRE, "agent");
      asm volatile("s_waitcnt vmcnt(0)" ::: "memory");
    }
  }
  __syncthreads();
}

DI void sincos_d(float angf, float& sn, float& cs) {
  const double a = (double)angf;
  const double q = __builtin_rint(a * 0.63661977236758134308);
  double r = __builtin_fma(-q, 1.57079632679489655800e+00, a);
  r = __builtin_fma(-q, 6.12323399573676603587e-17, r);
  const int n = ((int)q) & 3;
  const double r2 = r * r;
  double sp = 1.0 / 6227020800.0;
  sp = sp * r2 - 1.0 / 39916800.0;
  sp = sp * r2 + 1.0 / 362880.0;
  sp = sp * r2 - 1.0 / 5040.0;
  sp = sp * r2 + 1.0 / 120.0;
  sp = sp * r2 - 1.0 / 6.0;
  sp = r + r * r2 * sp;
  double cp = -1.0 / 87178291200.0;
  cp = cp * r2 + 1.0 / 479001600.0;
  cp = cp * r2 - 1.0 / 3628800.0;
  cp = cp * r2 + 1.0 / 40320.0;
  cp = cp * r2 - 1.0 / 720.0;
  cp = cp * r2 + 1.0 / 24.0;
  cp = cp * r2 - 0.5;
  cp = 1.0 + r2 * cp;
  double s_, c_;
  if (n == 0) { s_ = sp; c_ = cp; }
  else if (n == 1) { s_ = cp; c_ = -sp; }
  else if (n == 2) { s_ = -sp; c_ = -cp; }
  else { s_ = -cp; c_ = sp; }
  sn = (float)s_; cs = (float)c_;
}

__device__ void wconv_tile(const float* __restrict__ W, const float* __restrict__ g, bf16_t* __restrict__ Wt, int N, int tile, float* lds, const int tid) {
  const int ntn = N >> 6;
  const int k0 = (tile / ntn) << 6, n0 = (tile % ntn) << 6;
  __syncthreads();
#pragma unroll
  for (int i = 0; i < 16; ++i) {
    const int k = i * 4 + (tid >> 6), n = tid & 63;
    float v = W[(size_t)(k0 + k) * N + n0 + n];
    if (g) v *= g[k0 + k];
    lds[k * 65 + n] = v;
  }
  __syncthreads();
#pragma unroll
  for (int i = 0; i < 16; ++i) {
    const int n = i * 4 + (tid >> 6), k = tid & 63;
    Wt[(size_t)(n0 + n) * 1024 + k0 + k] = (bf16_t)(pk2(lds[k * 65 + n], 0.f) & 0xffffu);
  }
}

template <bool FINAL>
__device__ void rms_rows(const float* X, bf16_t* H, float* O, const float* g) {
  const int t_ = opaque_tid();
  const int lane = t_ & 63;
  const int gw = (blockIdx.x * blockDim.x + t_) >> 6, nw = (gridDim.x * blockDim.x) >> 6;
  const __amdgpu_buffer_rsrc_t rsx = mk_rsrc(X);
  const __amdgpu_buffer_rsrc_t rso = mk_rsrc(FINAL ? (const void*)O : (const void*)X);
  constexpr int RB = 2;
  for (int rbase = gw; rbase < MTOK; rbase += nw * RB) {
    f32x4 v[RB][4];
#pragma unroll
    for (int q = 0; q < RB; ++q) {
      const int row = min(rbase + q * nw, MTOK - 1);
#pragma unroll
      for (int i = 0; i < 4; ++i) v[q][i] = __builtin_bit_cast(f32x4, ld16(rsx, ((size_t)row * DM + i * 256 + lane * 4) * 4));
    }
#pragma unroll
    for (int q = 0; q < RB; ++q) {
      const int row = rbase + q * nw;
      if (row < MTOK) {
        float ss = 0.f;
#pragma unroll
        for (int i = 0; i < 4; ++i) ss += v[q][i][0] * v[q][i][0] + v[q][i][1] * v[q][i][1] + v[q][i][2] * v[q][i][2] + v[q][i][3] * v[q][i][3];
#pragma unroll
        for (int o = 32; o >= 1; o >>= 1) ss += __shfl_xor(ss, o);
        const float rstd = rsqrtf(ss * (1.0f / DM) + EPSV);
#pragma unroll
        for (int i = 0; i < 4; ++i) {
          if (FINAL) {
            const f32x4 gg = *(const f32x4*)(g + i * 256 + lane * 4);
            f32x4 o = v[q][i] * rstd * gg;
            __builtin_amdgcn_raw_buffer_store_b128(__builtin_bit_cast(u32x4, o), rso, (int)(unsigned)(((size_t)row * DM + i * 256 + lane * 4) * 4), 0, 16);
          } else {
            u32x2 o;
            o[0] = pk2(v[q][i][0] * rstd, v[q][i][1] * rstd);
            o[1] = pk2(v[q][i][2] * rstd, v[q][i][3] * rstd);
            *(u32x2*)(H + (size_t)row * DM + i * 256 + lane * 4) = o;
          }
        }
      }
    }
  }
}

constexpr int LROW = 144;
template <bool SWAP>
DI void gemm_mainloop(const bf16_t* __restrict__ A, const bf16_t* __restrict__ Bm, int m0, int n0, char* lds, f32x16 (&acc)[1][2]) {
  const int tid = opaque_tid(), w = tid >> 6, lane = tid & 63, r = lane & 31, h = lane >> 5;
  const int wm = w & 3, wn = w >> 2;
#pragma unroll
  for (int j = 0; j < 2; ++j)
#pragma unroll
    for (int e = 0; e < 16; ++e) acc[0][j][e] = 0.f;
  u32x4 ra[2], rb[2];
  const __amdgpu_buffer_rsrc_t rsa = mk_rsrc(A), rsb = mk_rsrc(Bm);
  const unsigned oa = (unsigned)(((size_t)(m0 + (tid >> 3)) * 1024 + (tid & 7) * 8) * 2);
  const unsigned ob = (unsigned)(((size_t)(n0 + (tid >> 3)) * 1024 + (tid & 7) * 8) * 2);
#pragma unroll
  for (int i = 0; i < 2; ++i) {
    ra[i] = ld16(rsa, oa + i * 64 * 2048);
    rb[i] = ld16(rsb, ob + i * 64 * 2048);
  }
  const int soff = (tid >> 3) * LROW + (tid & 7) * 16;
  __syncthreads();
#pragma unroll
  for (int i = 0; i < 2; ++i) {
    *(u32x4*)(lds + soff + i * 64 * LROW) = ra[i];
    *(u32x4*)(lds + 128 * LROW + soff + i * 64 * LROW) = rb[i];
  }
#pragma unroll
  for (int i = 0; i < 2; ++i) {
    ra[i] = ld16(rsa, oa + i * 64 * 2048 + 128);
    rb[i] = ld16(rsb, ob + i * 64 * 2048 + 128);
  }
  __syncthreads();
  for (int kt = 0; kt < 16; ++kt) {
    const char* ldsA = lds + (kt & 1) * 256 * LROW;
    const char* ldsB = ldsA + 128 * LROW;
    char* nb = lds + ((kt + 1) & 1) * 256 * LROW;
    const bool st = (kt + 1 < 16), ldn = (kt + 2 < 16);
#pragma unroll
    for (int ks = 0; ks < 4; ++ks) {
      const bf16x8 af = *(const bf16x8*)(ldsA + (32 * wm + r) * LROW + (16 * ks + 8 * h) * 2);
      bf16x8 bfr[2];
#pragma unroll
      for (int j = 0; j < 2; ++j) bfr[j] = *(const bf16x8*)(ldsB + (64 * wn + 32 * j + r) * LROW + (16 * ks + 8 * h) * 2);
#pragma unroll
      for (int j = 0; j < 2; ++j) {
        if (SWAP) acc[0][j] = MFMA(bfr[j], af, acc[0][j]);
        else acc[0][j] = MFMA(af, bfr[j], acc[0][j]);
      }
      const int i = ks >> 1;
      if ((ks & 1) == 0) {
        if (st) *(u32x4*)(nb + soff + i * 64 * LROW) = ra[i];
        if (ldn) ra[i] = ld16(rsa, oa + i * 64 * 2048 + (kt + 2) * 128);
      } else {
        if (st) *(u32x4*)(nb + 128 * LROW + soff + i * 64 * LROW) = rb[i];
        if (ldn) rb[i] = ld16(rsb, ob + i * 64 * 2048 + (kt + 2) * 128);
      }
      __builtin_amdgcn_sched_barrier(0);
    }
    __syncthreads();
  }
}

__device__ void inproj_tile(const Params& p, int l, int tile, char* lds) {
  const int tid = opaque_tid(), w = tid >> 6, lane = tid & 63, r = lane & 31, h = lane >> 5;
  const int wm = w & 3, wn = w >> 2;
  const int nt = tile % 26, mt = tile / 26;
  const int m0 = mt * 128, n0 = nt * 128;
  const bf16_t* Hb = (const bf16_t*)(p.ws + OFF_H);
  const bf16_t* Wt = (const bf16_t*)(p.ws + OFF_WIN) + (size_t)l * DIN * 1024;
  const bool isV = (nt == 3) || (nt == 9) || (nt == 16) || (nt == 17) || (nt == 23);
  const int hc = (n0 >> 6) + wn;
  f32x16 acc[1][2];
  if (isV) {
    gemm_mainloop<false>(Hb, Wt, m0, n0, lds, acc);
    bf16_t* dst; int nh, vh;
    if (hc < 8) { dst = (bf16_t*)(p.ws + OFF_VA); nh = 2; vh = hc - 6; }
    else if (hc < 20) { dst = (bf16_t*)(p.ws + OFF_VB); nh = 2; vh = hc - 18; }
    else if (hc < 36) { dst = (bf16_t*)(p.ws + OFF_VC); nh = 4; vh = hc - 32; }
    else { dst = (bf16_t*)(p.ws + OFF_VD); nh = 2; vh = hc - 46; }
    const int b = m0 >> 13, s0 = (m0 & 8191) + 32 * wm;
    char* slab = lds + w * 5120;
#pragma unroll
    for (int j = 0; j < 2; ++j)
#pragma unroll
      for (int g = 0; g < 4; ++g) {
        u32x2 o;
        o[0] = pk2(acc[0][j][4 * g + 0], acc[0][j][4 * g + 1]);
        o[1] = pk2(acc[0][j][4 * g + 2], acc[0][j][4 * g + 3]);
        *(u32x2*)(slab + (32 * j + r) * 80 + (8 * g + 4 * h) * 2) = o;
      }
    asm volatile("s_waitcnt lgkmcnt(0)" ::: "memory");
    bf16_t* vbase = dst + ((size_t)(b * nh + vh) * 64) * SEQ + s0;
#pragma unroll
    for (int it = 0; it < 4; ++it) {
      const int idx = lane + 64 * it, d = idx >> 2, c = idx & 3;
      const u32x4 vv = *(const u32x4*)(slab + d * 80 + c * 16);
      *(u32x4*)(vbase + (size_t)d * SEQ + c * 8) = vv;
    }
    return;
  }
  gemm_mainloop<true>(Hb, Wt, m0, n0, lds, acc);
  int branch, idx;
  if (hc < 12) { branch = 0; idx = hc; }
  else if (hc < 24) { branch = 1; idx = hc - 12; }
  else if (hc < 40) { branch = 2; idx = hc - 24; }
  else { branch = 3; idx = hc - 40; }
  int kind, head;
  if (branch == 2) {
    if (idx < 4) { kind = 0; head = idx; } else if (idx < 8) { kind = 1; head = idx - 4; } else { kind = 3; head = idx - 12; }
  } else {
    if (idx < 4) { kind = 0; head = idx; } else if (idx < 6) { kind = 1; head = idx - 4; } else { kind = 3; head = idx - 8; }
  }
  constexpr int RROW = 272;
  const bool needs_rope = (kind != 3) && (branch != 2);
  if (needs_rope) {
    const int s0 = m0 & 8191;
    const __amdgpu_buffer_rsrc_t rst = mk_rsrc(p.ws + OFF_T32);
    if (branch == 0) {
      for (int idx = tid; idx < 66 * 16; idx += 512) {
        const int row = idx >> 4, c = idx & 15;
        const int pos = row < 64 ? row : (s0 >> 6) + (row - 64);
        *(u32x4*)(lds + row * RROW + c * 16) = ld16(rst, (size_t)(pos * 16 + c) * 16);
      }
      if (tid < 64) ((float*)(lds + 66 * RROW))[tid] = (kind == 0 ? p.qn_a : p.kn_a)[l * 64 + tid];
    } else {
      for (int idx = tid; idx < 128 * 16; idx += 512) {
        const int row = idx >> 4, c = idx & 15;
        *(u32x4*)(lds + row * RROW + c * 16) = ld16(rst, (size_t)((s0 + row) * 16 + c) * 16);
      }
    }
    __syncthreads();
  }
  const float* gl = (const float*)(lds + 66 * RROW);
#pragma unroll
  for (int i = 0; i < 1; ++i) {
    const int token = m0 + 32 * wm + r;
    const int tl = 32 * wm + r;
    const int b = token >> 13, s = token & 8191;
    f32x16 v0 = acc[i][0], v1 = acc[i][1];
    u32x2 pkd[2][4];
    const int token0 = m0 + 32 * wm;
    bf16_t* rowbase; int rstride;
    if (kind == 3) {
      rowbase = (bf16_t*)(p.ws + OFF_GATE) + (size_t)token0 * 1024 + branch * 256 + head * 64; rstride = 1024;
#pragma unroll
      for (int g = 0; g < 4; ++g) {
        float t[8];
#pragma unroll
        for (int e = 0; e < 4; ++e) {
          const float a0 = v0[4 * g + e], a1 = v1[4 * g + e];
          t[e] = a0 * __builtin_amdgcn_rcpf(1.f + __builtin_amdgcn_exp2f(-a0 * LOG2E));
          t[4 + e] = a1 * __builtin_amdgcn_rcpf(1.f + __builtin_amdgcn_exp2f(-a1 * LOG2E));
        }
        u32x2 o0, o1;
        o0[0] = pk2(t[0], t[1]); o0[1] = pk2(t[2], t[3]);
        o1[0] = pk2(t[4], t[5]); o1[1] = pk2(t[6], t[7]);
        pkd[0][g] = o0; pkd[1][g] = o1;
      }
    } else {
    if (branch == 0) {
      float ss = 0.f;
#pragma unroll
      for (int e = 0; e < 16; ++e) ss += v0[e] * v0[e] + v1[e] * v1[e];
      ss += xor32(ss);
      const float rstd = rsqrtf(ss * (1.f / 64.f) + EPSV);
#pragma unroll
      for (int e = 0; e < 16; ++e) {
        v0[e] = v0[e] * rstd * gl[crow(e, h)];
        v1[e] = v1[e] * rstd * gl[32 + crow(e, h)];
      }
    }
    if (branch == 0 || branch == 3) {
      const int row0 = (branch == 0) ? (64 + (tl >> 6)) : tl;
      const int row1 = (branch == 0) ? (tl & 63) : tl;
#pragma unroll
      for (int e = 0; e < 8; ++e) {
        const int jf = crow(e, h);
        const float2 c0 = *(const float2*)(lds + row0 * RROW + jf * 16);
        const float2 c1 = *(const float2*)(lds + row1 * RROW + jf * 16);
        const float a1 = v0[e], a2 = v0[e + 8];
        v0[e] = a1 * c0.x - a2 * c0.y; v0[e + 8] = a2 * c0.x + a1 * c0.y;
        const float b1 = v1[e], b2 = v1[e + 8];
        v1[e] = b1 * c1.x - b2 * c1.y; v1[e + 8] = b2 * c1.x + b1 * c1.y;
      }
    } else if (branch == 1) {
#pragma unroll
      for (int e = 0; e < 16; ++e) {
        const int jf = crow(e, h);
        const float2 c = *(const float2*)(lds + tl * RROW + jf * 8);
        const float a1 = v0[e], a2 = v1[e];
        v0[e] = a1 * c.x - a2 * c.y; v1[e] = a2 * c.x + a1 * c.y;
      }
    }
    float sc = 1.f;
    if (kind == 0) sc = (branch == 3) ? (0.17677669529663687f * LOG2E) : (0.125f * LOG2E);
    const int b0 = token0 >> 13, s0w = token0 & 8191;
    if (kind == 0) {
      const size_t qoff = (branch == 0) ? OFF_QA : (branch == 1) ? OFF_QB : (branch == 2) ? OFF_QC : OFF_QD;
      rowbase = (bf16_t*)(p.ws + qoff) + ((size_t)(b0 * 4 + head) * SEQ + s0w) * 64;
    } else {
      const size_t koff = (branch == 0) ? OFF_KA : (branch == 1) ? OFF_KB : (branch == 2) ? OFF_KC : OFF_KD;
      const int nh = (branch == 2) ? 4 : 2;
      rowbase = (bf16_t*)(p.ws + koff) + ((size_t)(b0 * nh + head) * SEQ + s0w) * 64;
    }
    rstride = 64;
#pragma unroll
    for (int g = 0; g < 4; ++g) {
      u32x2 o0, o1;
      o0[0] = pk2(v0[4 * g] * sc, v0[4 * g + 1] * sc); o0[1] = pk2(v0[4 * g + 2] * sc, v0[4 * g + 3] * sc);
      o1[0] = pk2(v1[4 * g] * sc, v1[4 * g + 1] * sc); o1[1] = pk2(v1[4 * g + 2] * sc, v1[4 * g + 3] * sc);
      pkd[0][g] = o0; pkd[1][g] = o1;
    }
    }
    char* slab = lds + 36864 + w * 4608;
#pragma unroll
    for (int j = 0; j < 2; ++j)
#pragma unroll
      for (int g = 0; g < 4; ++g) *(u32x2*)(slab + r * 144 + (32 * j + 8 * g + 4 * h) * 2) = pkd[j][g];
    asm volatile("s_waitcnt lgkmcnt(0)" ::: "memory");
#pragma unroll
    for (int it = 0; it < 4; ++it) {
      const int row = (lane >> 3) + 8 * it, c = lane & 7;
      const u32x4 vv = *(const u32x4*)(slab + row * 144 + c * 16);
      *(u32x4*)(rowbase + (size_t)row * rstride + c * 8) = vv;
    }
  }
}

__device__ void outproj_tile(const Params& p, int l, int tile, char* lds, const float* __restrict__ xin, float* __restrict__ xout) {
  const int tid = opaque_tid(), w = tid >> 6, lane = tid & 63, r = lane & 31, h = lane >> 5;
  const int wm = w & 3, wn = w >> 2;
  const int nt = tile & 7, mt = tile >> 3;
  const int m0 = mt * 128, n0 = nt * 128;
  const bf16_t* Mx = (const bf16_t*)(p.ws + OFF_MIX);
  const bf16_t* Wt = (const bf16_t*)(p.ws + OFF_WOUT) + (size_t)l * 1024 * 1024;
  f32x16 acc[1][2];
  const __amdgpu_buffer_rsrc_t rsxin = mk_rsrc(xin);
  unsigned xr[16];
#pragma unroll
  for (int e = 0; e < 16; ++e) xr[e] = ld4(rsxin, ((size_t)(m0 + 32 * wm + crow(e, h)) * DM + (n0 + 64 * wn + r)) * 4);
  gemm_mainloop<false>(Mx, Wt, m0, n0, lds, acc);
#pragma unroll
  for (int j = 0; j < 2; ++j) {
    const int n = n0 + 64 * wn + 32 * j + r;
#pragma unroll
    for (int e = 0; e < 16; ++e) {
      const int m = m0 + 32 * wm + crow(e, h);
      const size_t o = (size_t)m * DM + n;
      const unsigned xv = (j == 0) ? xr[e] : ld4(rsxin, o * 4);
      xout[o] = __uint_as_float(xv) + acc[0][j][e];
    }
  }
}

enum { MA = 0, MB = 1, MC = 2, MD = 3 };

template <int MODE>
__device__ void attn_item(const Params& p, int l, int item, char* lds) {
  const int tid = opaque_tid(), w = tid >> 6, lane = tid & 63, r = lane & 31, h = lane >> 5;
  const int qg = w & 3, role = w >> 2;
  constexpr int NKS = (MODE == MD) ? 2 : 4;
  constexpr bool FAST = (MODE == MA || MODE == MD);
  constexpr bool NEGM = FAST;
  constexpr float P_THR = 256.f;
  float* ldsR = (float*)(lds + 256 * LROW);

  int b, qtok, ktlo, kthi, head_out, koff = 0;
  const bf16_t *Qp, *Kg, *Vg;
  int qrow = 0, rs = 0, qcol0 = 0;
  if (MODE == MA || MODE == MB) {
    b = item >> 7; const int kvh = (item >> 6) & 1, qb = item & 63;
    qtok = qb * 128 + 32 * qg + r;
    head_out = kvh * 2 + role;
    Qp = (const bf16_t*)(p.ws + (MODE == MA ? OFF_QA : OFF_QB)) + ((size_t)(b * 4 + head_out) * SEQ + qtok) * 64 + 8 * h;
    const int kvrow = b * 2 + kvh;
    Kg = (const bf16_t*)(p.ws + (MODE == MA ? OFF_KA : OFF_KB)) + (size_t)kvrow * SEQ * 64;
    Vg = (const bf16_t*)(p.ws + (MODE == MA ? OFF_VA : OFF_VB)) + (size_t)kvrow * 64 * SEQ;
    if (MODE == MA) { ktlo = 0; kthi = 128; }
    else { ktlo = max(0, qb * 2 - 2); kthi = min(128, qb * 2 + 4); }
  } else if (MODE == MD) {
    b = item >> 8; const int hq = (item >> 6) & 3, qb = item & 63;
    qtok = qb * 128 + 32 * qg + r;
    head_out = hq;
    koff = 32 * role;
    Qp = (const bf16_t*)(p.ws + OFF_QD) + ((size_t)(b * 4 + hq) * SEQ + qtok) * 64 + koff + 8 * h;
    const int kvrow = b * 2 + (hq >> 1);
    Kg = (const bf16_t*)(p.ws + OFF_KD) + (size_t)kvrow * SEQ * 64;
    Vg = (const bf16_t*)(p.ws + OFF_VD) + (size_t)kvrow * 64 * SEQ;
    ktlo = 0; kthi = 128;
  } else {
    b = item >> 7; const int hh = (item >> 5) & 3, rg = item & 31;
    qrow = rg * 4 + qg;
    rs = min(max(qrow - 4, 0), 120);
    qcol0 = 32 * role;
    qtok = qrow * 64 + qcol0 + r;
    head_out = hh;
    Qp = (const bf16_t*)(p.ws + OFF_QC) + ((size_t)(b * 4 + hh) * SEQ + qtok) * 64 + 8 * h;
    const int kvrow = b * 4 + hh;
    Kg = (const bf16_t*)(p.ws + OFF_KC) + (size_t)kvrow * SEQ * 64;
    Vg = (const bf16_t*)(p.ws + OFF_VC) + (size_t)kvrow * 64 * SEQ;
    ktlo = min(max(rg * 4 - 4, 0), 120);
    kthi = min(max(rg * 4 + 3 - 4, 0), 120) + 8;
    const float* rp = p.rpb_c + ((size_t)l * 4 + hh) * 465;
    for (int i = tid; i < 465; i += 512) ldsR[i] = rp[i] * LOG2E;
  }

  const __amdgpu_buffer_rsrc_t rsw = mk_rsrc(p.ws);
  bf16x8 qf[NKS];
#pragma unroll
  for (int ks = 0; ks < NKS; ++ks) qf[ks] = __builtin_bit_cast(bf16x8, ld16(rsw, (size_t)((const char*)(Qp + 16 * ks) - p.ws)));

  f32x16 O[2];
#pragma unroll
  for (int db = 0; db < 2; ++db)
#pragma unroll
    for (int e = 0; e < 16; ++e) O[db][e] = 0.f;
  float mrun, lrun;
  if (MODE == MB) { mrun = p.sink_b[l * 4 + head_out] * LOG2E; lrun = 0.5f; }
  else { mrun = NEG; lrun = 0.f; }
  f32x16 negm;
  if (FAST) {
    f32x16 s0;
#pragma unroll
    for (int e = 0; e < 16; ++e) s0[e] = 0.f;
#pragma unroll
    for (int ks = 0; ks < NKS; ++ks) {
      const bf16_t* kp = Kg + ((size_t)ktlo * 64 + r) * 64 + koff + 16 * ks + 8 * h;
      const bf16x8 k0 = __builtin_bit_cast(bf16x8, ld16(rsw, (size_t)((const char*)kp - p.ws)));
      s0 = MFMA(k0, qf[ks], s0);
    }
    float m0 = s0[0];
#pragma unroll
    for (int e = 1; e < 16; ++e) m0 = fmaxf(m0, s0[e]);
    m0 = fmaxf(m0, xor32(m0));
    mrun = m0;
#pragma unroll
    for (int e = 0; e < 16; ++e) negm[e] = -m0;
  }
  u32x4 kreg, vreg;
  const int lrow = tid >> 3, lch = tid & 7;
  const bf16_t* kgp = Kg + (size_t)lrow * 64 + lch * 8;
  const bf16_t* vgp = Vg + (size_t)lrow * SEQ + lch * 8;
  kreg = ld16(rsw, (size_t)((const char*)(kgp + (size_t)ktlo * 64 * 64) - p.ws));
  vreg = ld16(rsw, (size_t)((const char*)(vgp + ktlo * 64) - p.ws));
  const int soff = lrow * LROW + lch * 16;
  const int vsoff = lrow * LROW + (lch >> 1) * 32 + (lch & 1) * 8;

  __syncthreads();
  *(u32x4*)(lds + soff) = kreg;
  { u32x2 lo_ = {vreg[0], vreg[1]}, hi_ = {vreg[2], vreg[3]}; *(u32x2*)(lds + 64 * LROW + vsoff) = lo_; *(u32x2*)(lds + 64 * LROW + vsoff + 16) = hi_; }
  if (ktlo + 1 < kthi) {
    kreg = ld16(rsw, (size_t)((const char*)(kgp + (size_t)(ktlo + 1) * 64 * 64) - p.ws));
    vreg = ld16(rsw, (size_t)((const char*)(vgp + (ktlo + 1) * 64) - p.ws));
  }
  __syncthreads();
  for (int kt = ktlo; kt < kthi; ++kt) {
    const int cur = (kt - ktlo) & 1;
    const char* ldsK = lds + cur * 128 * LROW;
    const char* ldsV = ldsK + 64 * LROW;
    if (kt + 1 < kthi) {
      char* nb = lds + (cur ^ 1) * 128 * LROW;
      *(u32x4*)(nb + soff) = kreg;
      { u32x2 lo_ = {vreg[0], vreg[1]}, hi_ = {vreg[2], vreg[3]}; *(u32x2*)(nb + 64 * LROW + vsoff) = lo_; *(u32x2*)(nb + 64 * LROW + vsoff + 16) = hi_; }
    }
    if (kt + 2 < kthi) {
      kreg = ld16(rsw, (size_t)((const char*)(kgp + (size_t)(kt + 2) * 64 * 64) - p.ws));
      vreg = ld16(rsw, (size_t)((const char*)(vgp + (kt + 2) * 64) - p.ws));
    }
    bool active = true;
    if (MODE == MC) active = (kt >= rs) && (kt < rs + 8);
    if (active) {
#pragma nounroll
      for (int kb = 0; kb < 2; ++kb) {
        bf16x8 pf[2];
        if (FAST) {
          f32x16 S = negm;
#pragma unroll
          for (int ks = 0; ks < NKS; ++ks) {
            const bf16x8 k0 = *(const bf16x8*)(ldsK + (32 * kb + r) * LROW + (koff + 16 * ks + 8 * h) * 2);
            S = MFMA(k0, qf[ks], S);
          }
          float ls = 0.f;
#pragma unroll
          for (int e = 0; e < 16; ++e) { S[e] = __builtin_amdgcn_exp2f(S[e]); ls += S[e]; }
          if (__any(!(ls <= P_THR))) {
            S = negm;
#pragma unroll
            for (int ks = 0; ks < NKS; ++ks) {
              const bf16x8 k0 = *(const bf16x8*)(ldsK + (32 * kb + r) * LROW + (koff + 16 * ks + 8 * h) * 2);
              S = MFMA(k0, qf[ks], S);
            }
            float mx = S[0];
#pragma unroll
            for (int e = 1; e < 16; ++e) mx = fmaxf(mx, S[e]);
            mx = fmaxf(mx, xor32(mx));
            const float d = fmaxf(mx, 0.f);
            const float alpha = __builtin_amdgcn_exp2f(-d);
            mrun += d;
            lrun *= alpha;
#pragma unroll
            for (int db = 0; db < 2; ++db)
#pragma unroll
              for (int e = 0; e < 16; ++e) O[db][e] *= alpha;
#pragma unroll
            for (int e = 0; e < 16; ++e) negm[e] -= d;
            ls = 0.f;
#pragma unroll
            for (int e = 0; e < 16; ++e) { S[e] = __builtin_amdgcn_exp2f(S[e] - d); ls += S[e]; }
          }
#pragma unroll
          for (int s = 0; s < 2; ++s) {
            u32x4 pk;
            pk[0] = pk2(S[8 * s + 0], S[8 * s + 1]); pk[1] = pk2(S[8 * s + 2], S[8 * s + 3]);
            pk[2] = pk2(S[8 * s + 4], S[8 * s + 5]); pk[3] = pk2(S[8 * s + 6], S[8 * s + 7]);
            pf[s] = __builtin_bit_cast(bf16x8, pk);
          }
          lrun += ls;
        } else {
          f32x16 S;
#pragma unroll
          for (int e = 0; e < 16; ++e) S[e] = 0.f;
#pragma unroll
          for (int ks = 0; ks < NKS; ++ks) {
            const bf16x8 k0 = *(const bf16x8*)(ldsK + (32 * kb + r) * LROW + (16 * ks + 8 * h) * 2);
            S = MFMA(k0, qf[ks], S);
          }
          if (MODE == MB) {
#pragma unroll
            for (int e = 0; e < 16; ++e) {
              const int kpos = kt * 64 + 32 * kb + crow(e, h);
              const int dlt = qtok - kpos;
              const bool ok = (dlt <= 128) && (dlt >= -128);
              S[e] = ok ? S[e] : NEG;
            }
          }
          if (MODE == MC) {
            const int dr = kt - qrow + 7;
            const int qcol = qcol0 + r;
            const int cs = min(max(qcol - 8, 0), 48);
#pragma unroll
            for (int e = 0; e < 16; ++e) {
              const int kcol = 32 * kb + crow(e, h);
              const bool ok = (kcol >= cs) && (kcol < cs + 16);
              const int dc = min(max(kcol - qcol, -15), 15) + 15;
              const float bias = ldsR[dr * 31 + dc];
              S[e] = ok ? (S[e] + bias) : NEG;
            }
          }
          float mx = S[0];
#pragma unroll
          for (int e = 1; e < 16; ++e) mx = fmaxf(mx, S[e]);
          mx = fmaxf(mx, xor32(mx));
          if (__any(mx > mrun)) {
            const float mn = fmaxf(mrun, mx);
            const float alpha = __builtin_amdgcn_exp2f(mrun - mn);
            mrun = mn;
            lrun *= alpha;
#pragma unroll
            for (int db = 0; db < 2; ++db)
#pragma unroll
              for (int e = 0; e < 16; ++e) O[db][e] *= alpha;
          }
          const float mn = mrun;
          float ls = 0.f;
#pragma unroll
          for (int e = 0; e < 16; ++e) {
            const float pvv = __builtin_amdgcn_exp2f(S[e] - mn);
            S[e] = pvv;
            ls += pvv;
          }
          lrun += ls;
#pragma unroll
          for (int s = 0; s < 2; ++s) {
            u32x4 pk;
            pk[0] = pk2(S[8 * s + 0], S[8 * s + 1]); pk[1] = pk2(S[8 * s + 2], S[8 * s + 3]);
            pk[2] = pk2(S[8 * s + 4], S[8 * s + 5]); pk[3] = pk2(S[8 * s + 6], S[8 * s + 7]);
            pf[s] = __builtin_bit_cast(bf16x8, pk);
          }
        }
#pragma unroll
        for (int s = 0; s < 2; ++s)
#pragma unroll
          for (int db = 0; db < 2; ++db) {
            const bf16x8 vf = *(const bf16x8*)(ldsV + (32 * db + r) * LROW + (32 * kb + 16 * s) * 2 + 16 * h);
            O[db] = MFMA(vf, pf[s], O[db]);
          }
      }
    }
    __syncthreads();
  }

  bf16_t* mix = (bf16_t*)(p.ws + OFF_MIX);
  lrun += xor32(lrun);
  const float inv = 1.f / lrun;
  if (MODE == MD) {
    float* xch = (float*)lds + (size_t)qg * 32 * 64 + lane;
    __syncthreads();
    if (role == 1) {
#pragma unroll
      for (int db = 0; db < 2; ++db)
#pragma unroll
        for (int e = 0; e < 16; ++e) xch[(db * 16 + e) * 64] = O[db][e] * inv;
    }
    __syncthreads();
    if (role == 1) return;
    const float lam = __uint_as_float(ld4(rsw, OFF_CTRL + (16 + l * 2 + 0) * 4)), omli = __uint_as_float(ld4(rsw, OFF_CTRL + (16 + l * 2 + 1) * 4));
    f32x16 o[2];
    float ss = 0.f;
#pragma unroll
    for (int db = 0; db < 2; ++db)
#pragma unroll
      for (int e = 0; e < 16; ++e) {
        const float t = O[db][e] * inv - lam * xch[(db * 16 + e) * 64];
        o[db][e] = t;
        ss += t * t;
      }
    ss += xor32(ss);
    const float rstd = rsqrtf(ss * (1.f / 64.f) + EPSV) * omli;
    const size_t base = (size_t)(b * SEQ + qtok) * 1024 + 768 + head_out * 64 + 4 * h;
    const float* sg = p.subln + l * 64 + 4 * h;
#pragma unroll
    for (int db = 0; db < 2; ++db)
#pragma unroll
      for (int g = 0; g < 4; ++g) {
        const size_t off = base + 32 * db + 8 * g;
        const u32x2 gv = ld8(rsw, OFF_GATE + off * 2);
        const float g0 = __uint_as_float(gv[0] << 16), g1 = __uint_as_float(gv[0] & 0xffff0000u);
        const float g2 = __uint_as_float(gv[1] << 16), g3 = __uint_as_float(gv[1] & 0xffff0000u);
        const float* sgp = sg + 32 * db + 8 * g;
        u32x2 ov;
        ov[0] = pk2(o[db][4 * g + 0] * rstd * sgp[0] * g0, o[db][4 * g + 1] * rstd * sgp[1] * g1);
        ov[1] = pk2(o[db][4 * g + 2] * rstd * sgp[2] * g2, o[db][4 * g + 3] * rstd * sgp[3] * g3);
        *(u32x2*)(mix + off) = ov;
      }
  } else {
    const int brc = (MODE == MA) ? 0 : (MODE == MB) ? 256 : 512;
    const size_t base = (size_t)(b * SEQ + qtok) * 1024 + brc + head_out * 64 + 4 * h;
#pragma unroll
    for (int db = 0; db < 2; ++db)
#pragma unroll
      for (int g = 0; g < 4; ++g) {
        const size_t off = base + 32 * db + 8 * g;
        const u32x2 gv = ld8(rsw, OFF_GATE + off * 2);
        const float g0 = __uint_as_float(gv[0] << 16), g1 = __uint_as_float(gv[0] & 0xffff0000u);
        const float g2 = __uint_as_float(gv[1] << 16), g3 = __uint_as_float(gv[1] & 0xffff0000u);
        u32x2 ov;
        ov[0] = pk2(O[db][4 * g + 0] * inv * g0, O[db][4 * g + 1] * inv * g1);
        ov[1] = pk2(O[db][4 * g + 2] * inv * g2, O[db][4 * g + 3] * inv * g3);
        *(u32x2*)(mix + off) = ov;
      }
  }
}

constexpr int N_D = 512, N_A = 256, N_B = 256, N_C = 256;
constexpr int N_ATT = N_D + N_A + N_B + N_C;

__device__ void phase_prep(const Params& p, char* lds) {
  const int tid = opaque_tid();
  const int gtid = blockIdx.x * blockDim.x + tid, nth = gridDim.x * blockDim.x;
  if (blockIdx.x == 0 && tid == 0) {
    float* cf = (float*)(p.ws + OFF_CTRL) + 16;
    for (int l = 0; l < 2; ++l) {
      float s1 = 0.f, s2 = 0.f;
      for (int i = 0; i < 32; ++i) { s1 += p.lq1[l * 32 + i] * p.lk1[l * 32 + i]; s2 += p.lq2[l * 32 + i] * p.lk2[l * 32 + i]; }
      const float li = (l == 0) ? 0.2f : 0.35550906759096934f;
      cf[l * 2 + 0] = __expf(s1) - __expf(s2) + li;
      cf[l * 2 + 1] = 1.0f - li;
    }
  }
  float2* T32 = (float2*)(p.ws + OFF_T32);
  for (int i = gtid; i < SEQ * 32; i += nth) {
    const int pos = i >> 5, j = i & 31;
    const float ang = (float)pos * INV32[j];
    float sn, cs;
    sincos_d(ang, sn, cs);
    T32[i] = make_float2(cs, sn);
  }
  const int half = tid >> 8, tl = tid & 255;
  for (int tp = blockIdx.x; tp < 832 + 256; tp += gridDim.x) {
    const int t = 2 * tp + half;
    const int l = t / 1088, tt = t % 1088;
    float* lf = (float*)(lds + half * 20480);
    if (tt < 832) wconv_tile(p.w_in + (size_t)l * 1024 * DIN, p.norm_g + l * 1024, (bf16_t*)(p.ws + OFF_WIN) + (size_t)l * DIN * 1024, DIN, tt, lf, tl);
    else wconv_tile(p.w_out + (size_t)l * 1024 * 1024, nullptr, (bf16_t*)(p.ws + OFF_WOUT) + (size_t)l * 1024 * 1024, 1024, tt - 832, lf, tl);
  }
  rms_rows<false>(p.x, (bf16_t*)(p.ws + OFF_H), nullptr, nullptr);
}

__device__ void phase_inproj(const Params& p, int l, char* lds) {
  if ((gridDim.x & 7) == 0) {
    const int xcd = blockIdx.x & 7, slot = blockIdx.x >> 3, slots = gridDim.x >> 3;
    for (int q = slot; q < 16 * 26; q += slots) {
      int mtl, nt;
      if (q < 384) { const int ng = q >> 7, rem = q & 127, w8 = rem & 63; mtl = (rem >> 6) * 8 + (w8 & 7); nt = ng * 8 + (w8 >> 3); }
      else { const int rem = q - 384; mtl = rem & 15; nt = 24 + (rem >> 4); }
      inproj_tile(p, l, (xcd * 16 + mtl) * 26 + nt, lds);
    }
  } else {
    for (int t = blockIdx.x; t < 128 * 26; t += gridDim.x) inproj_tile(p, l, t, lds);
  }
}

DI int fetch_item(unsigned* ctr, int* s_item) {
  __syncthreads();
  if (threadIdx.x == 0) *s_item = (int)atomicAdd(ctr, 1u);
  __syncthreads();
  return *s_item;
}

__device__ void phase_attn(const Params& p, int l, char* lds, int* s_item, int cidx) {
  unsigned* ctr = (unsigned*)(p.ws + OFF_CTRL) + cidx;
  int item = blockIdx.x;
  while (item < N_A) { attn_item<MA>(p, l, item, lds); item = (int)gridDim.x + fetch_item(ctr, s_item); }
  while (item < N_A + N_D) { attn_item<MD>(p, l, item - N_A, lds); item = (int)gridDim.x + fetch_item(ctr, s_item); }
  while (item < N_A + N_D + N_B) { attn_item<MB>(p, l, item - N_A - N_D, lds); item = (int)gridDim.x + fetch_item(ctr, s_item); }
  while (item < N_ATT) { attn_item<MC>(p, l, item - N_A - N_D - N_B, lds); item = (int)gridDim.x + fetch_item(ctr, s_item); }
}

__device__ void phase_outproj(const Params& p, int l, char* lds) {
  const float* xin = (l == 0) ? p.x : (const float*)(p.ws + OFF_X1);
  float* xout = (l == 0) ? (float*)(p.ws + OFF_X1) : p.out;
  if ((gridDim.x & 7) == 0) {
    const int xcd = blockIdx.x & 7, slot = blockIdx.x >> 3, slots = gridDim.x >> 3;
    for (int q = slot; q < 16 * 8; q += slots) {
      const int w8 = q & 63, mtl = (q >> 6) * 8 + (w8 & 7), nt = w8 >> 3;
      outproj_tile(p, l, (xcd * 16 + mtl) * 8 + nt, lds, xin, xout);
    }
  } else {
    for (int t = blockIdx.x; t < 128 * 8; t += gridDim.x) outproj_tile(p, l, t, lds, xin, xout);
  }
}

__global__ void __launch_bounds__(512, 4) fwd_megakernel(Params p) {
  __shared__ __attribute__((aligned(16))) char lds[4 * 128 * LROW];
  __shared__ int s_item;
  __shared__ uint4 xb_words;
  if (p.ws == nullptr) cg::this_grid().sync();
  if (threadIdx.x == 0) xb_words = make_uint4(0u, 0u, 0u, 0u);
  __syncthreads();
  XcdBarrier gb = xcd_barrier_post((unsigned*)(p.ws + OFF_BAR), (volatile LAS unsigned*)&xb_words);
  phase_prep(p, lds);
  xcd_barrier(gb);
  for (int l = 0; l < 2; ++l) {
    phase_inproj(p, l, lds);
    xcd_barrier(gb);
    phase_attn(p, l, lds, &s_item, l);
    xcd_barrier(gb);
#ifdef PROBE_ATTN2
    phase_attn(p, l, lds, &s_item, l + 2);
    xcd_barrier(gb);
#endif
#ifdef PROBE_GEMM2
    phase_inproj(p, l, lds);
    xcd_barrier(gb);
#endif
    phase_outproj(p, l, lds);
    xcd_barrier(gb);
    if (l == 0) {
      rms_rows<false>((const float*)(p.ws + OFF_X1), (bf16_t*)(p.ws + OFF_H), nullptr, nullptr);
      xcd_barrier(gb);
    } else {
      rms_rows<true>(p.out, nullptr, p.out, p.final_g);
    }
  }
}

extern "C" void kernel_launch(void* const* d_in, const int* in_sizes, int n_in, void* d_out,
                              int out_size, void* d_ws, size_t ws_size, hipStream_t stream) {
  static int grid_blocks = 0;
  if (!grid_blocks) {
    int dev = 0, cus = 0, per_cu = 0;
    (void)hipGetDevice(&dev);
    (void)hipDeviceGetAttribute(&cus, hipDeviceAttributeMultiprocessorCount, dev);
    (void)hipOccupancyMaxActiveBlocksPerMultiprocessor(&per_cu, fwd_megakernel, 512, 0);
    if (per_cu > 2) per_cu = 2;
    if (per_cu < 1) per_cu = 1;
    grid_blocks = cus * per_cu;
  }
  if (ws_size < WS_NEEDED) { fprintf(stderr, "workspace too small\n"); return; }
  Params p{};
  p.x = (const float*)d_in[0]; p.norm_g = (const float*)d_in[1]; p.w_in = (const float*)d_in[2]; p.w_out = (const float*)d_in[3];
  p.qn_a = (const float*)d_in[4]; p.kn_a = (const float*)d_in[5]; p.sink_b = (const float*)d_in[6]; p.rpb_c = (const float*)d_in[7];
  p.lq1 = (const float*)d_in[8]; p.lk1 = (const float*)d_in[9]; p.lq2 = (const float*)d_in[10]; p.lk2 = (const float*)d_in[11];
  p.subln = (const float*)d_in[12]; p.final_g = (const float*)d_in[13];
  p.out = (float*)d_out; p.ws = (char*)d_ws;
  (void)hipMemsetAsync(d_ws, 0, OFF_T32, stream);
  void* args[] = {&p};
  hipError_t e = hipLaunchCooperativeKernel((void*)fwd_megakernel, dim3(grid_blocks), dim3(512), args, 0, stream);
  if (e != hipSuccess) fprintf(stderr, "cooperative launch failed: %s (grid %d)\n", hipGetErrorString(e), grid_blocks);
}
```
